# Optimizing an MI355X kernel written in HIP

```python
import functools
import jax
import jax.numpy as jnp
from jax import lax
import numpy as np

D_MODEL = 2048
BATCH = 2
SEQ = 4096
DEPTH = 4

CTX_LEN = 256
GRID_W = 64
ROPE_BASE = 10000.0
NORM_EPS = 1e-6
NEG_INF = -1e30
QBLOCK = 128

MLA_HEADS = 4
MLA_NOPE = 128
MLA_ROPE = 64
MLA_V = 128
MLA_Q_LORA = 512
MLA_KV_LORA = 256
MLA_SCALE = (MLA_NOPE + MLA_ROPE) ** -0.5
POOL_WINDOWS = (2, 4, 8, 16)
POOL_GROUP = 128
POOL_WIDTH = POOL_GROUP * len(POOL_WINDOWS)
SWA_HEADS = 8
SWA_KV_HEADS = 2
SWA_HEAD_DIM = 64
SWA_WINDOW = 128
SWA_BLOCK = 128
NA_HEADS = 8
NA_HEAD_DIM = 64
NA_KH = 8
NA_KW = 16
NA_QC = 16
NA_KC = NA_QC + NA_KW
FFN_DIM = 5632

A_COLS = MLA_Q_LORA + MLA_KV_LORA + MLA_ROPE
B_COLS = POOL_WIDTH
C_COLS = (SWA_HEADS + 2 * SWA_KV_HEADS) * SWA_HEAD_DIM
D_COLS = 3 * NA_HEADS * NA_HEAD_DIM
IN_COLS = A_COLS + B_COLS + C_COLS + D_COLS
IN_SPLITS = (A_COLS, A_COLS + B_COLS, A_COLS + B_COLS + C_COLS)
MIX_OUT = MLA_HEADS * MLA_V + POOL_WIDTH + SWA_HEADS * SWA_HEAD_DIM + NA_HEADS * NA_HEAD_DIM

kernel_name = 'hybrid_pargroup_dit_block'

F32 = jnp.float32


def rms_norm(x, g):
    xf = x.astype(F32)
    y = xf * lax.rsqrt(jnp.mean(xf * xf, axis=-1, keepdims=True) + NORM_EPS)
    return (y * g.astype(F32)).astype(x.dtype)


def adaln(cond, w_mod, b_mod):
    return jnp.split(jax.nn.silu(cond) @ w_mod + b_mod, 6, axis=-1)


def modulate(h, shift, scale):
    return h * (1.0 + scale) + shift


def axial_angles(n, d_rot):
    t = jnp.arange(n)
    row = (t // GRID_W).astype(F32)
    col = (t % GRID_W).astype(F32)
    d_axis = d_rot // 2
    inv_freq = ROPE_BASE ** (-jnp.arange(0, d_axis, 2, dtype=F32) / d_axis)
    return (row[:, None] * inv_freq, col[:, None] * inv_freq)


def rope_segment(x, ang):
    cos = jnp.cos(ang)[:, None, :].astype(x.dtype)
    sin = jnp.sin(ang)[:, None, :].astype(x.dtype)
    x1, x2 = jnp.split(x, 2, axis=-1)
    return jnp.concatenate([x1 * cos - x2 * sin, x2 * cos + x1 * sin], axis=-1)


def axial_rope(x, ang):
    half = x.shape[-1] // 2
    return jnp.concatenate([rope_segment(x[..., :half], ang[0]), rope_segment(x[..., half:], ang[1])], axis=-1)


def map_query_blocks(fn, qs):
    b, n = qs[0].shape[:2]
    nb = n // QBLOCK
    blocks = tuple(jnp.moveaxis(q.reshape(b, nb, QBLOCK, *q.shape[2:]), 1, 0) for q in qs)
    out = lax.map(lambda qb: fn(*qb), blocks)
    return jnp.moveaxis(out, 0, 1).reshape(b, n, *out.shape[3:])


def mla_project(p, q_a_norm, w_qb, kv_a_norm, w_kvb, q_nope_norm, q_rope_norm, k_nope_norm, k_rope_norm, ang):
    b, n, _ = p.shape
    cq, ckv, kr = jnp.split(p, [MLA_Q_LORA, MLA_Q_LORA + MLA_KV_LORA], axis=-1)
    q = (rms_norm(cq, q_a_norm) @ w_qb).reshape(b, n, MLA_HEADS, MLA_NOPE + MLA_ROPE)
    kv = (rms_norm(ckv, kv_a_norm) @ w_kvb).reshape(b, n, MLA_HEADS, MLA_NOPE + MLA_V)
    q_nope = rms_norm(q[..., :MLA_NOPE], q_nope_norm)
    q_rope = rms_norm(q[..., MLA_NOPE:], q_rope_norm)
    k_nope = rms_norm(kv[..., :MLA_NOPE], k_nope_norm)
    v = kv[..., MLA_NOPE:]
    k_rope = rms_norm(kr, k_rope_norm)[:, :, None, :]
    if ang is not None:
        q_rope = axial_rope(q_rope, ang)
        k_rope = axial_rope(k_rope, ang)
    return q_nope, q_rope, k_nope, k_rope[:, :, 0, :], v


def mla_attend(q_nope, q_rope, k_nope, k_rope, v):
    s = (jnp.einsum('bqhd,bkhd->bhqk', q_nope, k_nope, preferred_element_type=F32)
         + jnp.einsum('bqhr,bkr->bhqk', q_rope, k_rope, preferred_element_type=F32))
    p = jax.nn.softmax(s * MLA_SCALE, axis=-1).astype(v.dtype)
    return jnp.einsum('bhqk,bkhd->bqhd', p, v)


def pool_mixer(u, w_pool, scale):
    b, n, _ = u.shape
    uf = u.astype(F32)
    csum = jnp.pad(jnp.cumsum(uf, axis=1), ((0, 0), (1, 0), (0, 0)))
    t = jnp.arange(n)
    diffs = []
    for g, w in enumerate(POOL_WINDOWS):
        sl = slice(g * POOL_GROUP, (g + 1) * POOL_GROUP)
        lo = jnp.clip(t - w // 2, 0, n)
        hi = jnp.clip(t + w // 2, 0, n)
        cs = csum[..., sl]
        mean = (cs[:, hi] - cs[:, lo]) / (hi - lo).astype(F32)[None, :, None]
        diffs.append(mean - uf[..., sl])
    d = jnp.stack(diffs, axis=2).astype(u.dtype)
    y = jnp.einsum('bngc,gcd->bngd', d, w_pool).reshape(b, n, POOL_WIDTH)
    return y * scale


def swa_project(p, q_norm, k_norm, ang):
    b, n, _ = p.shape
    q, k, v = jnp.split(p, [SWA_HEADS * SWA_HEAD_DIM, (SWA_HEADS + SWA_KV_HEADS) * SWA_HEAD_DIM], axis=-1)
    q = rms_norm(q.reshape(b, n, SWA_HEADS, SWA_HEAD_DIM), q_norm)
    k = rms_norm(k.reshape(b, n, SWA_KV_HEADS, SWA_HEAD_DIM), k_norm)
    v = v.reshape(b, n, SWA_KV_HEADS, SWA_HEAD_DIM)
    if ang is not None:
        q = axial_rope(q, ang)
        k = axial_rope(k, ang)
    return q, k, v


def swa_latent(q, k, v, k_ctx, v_ctx, sink):
    b, n, hq, d = q.shape
    hkv = k.shape[2]
    grp = hq // hkv
    blk = SWA_BLOCK
    nb = n // blk
    scale = d ** -0.5
    qg = q.reshape(b, nb, blk, hkv, grp, d)

    def band(t):
        tp = jnp.pad(t, ((0, 0), (blk, blk), (0, 0), (0, 0))).reshape(b, nb + 2, blk, hkv, d)
        return jnp.concatenate([tp[:, :-2], tp[:, 1:-1], tp[:, 2:]], axis=2)

    k_band, v_band = band(k), band(v)
    s_loc = jnp.einsum('bnqhgd,bnkhd->bnhgqk', qg, k_band, preferred_element_type=F32) * scale
    qpos = jnp.arange(nb)[:, None] * blk + jnp.arange(blk)[None, :]
    kpos = (jnp.arange(nb)[:, None] - 1) * blk + jnp.arange(3 * blk)[None, :]
    valid = ((jnp.abs(kpos[:, None, :] - qpos[:, :, None]) <= SWA_WINDOW)
             & (kpos[:, None, :] >= 0) & (kpos[:, None, :] < n))
    s_loc = jnp.where(valid[None, :, None, None], s_loc, NEG_INF)
    s_ctx = jnp.einsum('bnqhgd,bkhd->bnhgqk', qg, k_ctx, preferred_element_type=F32) * scale
    s_sink = jnp.broadcast_to(sink.astype(F32).reshape(hkv, grp)[:, :, None, None], s_loc.shape[:-1] + (1,))
    p = jax.nn.softmax(jnp.concatenate([s_loc, s_ctx, s_sink], axis=-1), axis=-1).astype(v.dtype)
    nk = 3 * blk
    n_ctx = k_ctx.shape[1]
    o = (jnp.einsum('bnhgqk,bnkhd->bnqhgd', p[..., :nk], v_band)
         + jnp.einsum('bnhgqk,bkhd->bnqhgd', p[..., nk:nk + n_ctx], v_ctx))
    return o.reshape(b, n, hq * d)


def ctx_attention(q, k, v, sink):
    b, nq, hq, d = q.shape
    hkv = k.shape[2]
    grp = hq // hkv
    nk = k.shape[1]
    qg = q.reshape(b, nq, hkv, grp, d)
    s = jnp.einsum('bqhgd,bkhd->bhgqk', qg, k, preferred_element_type=F32) * (d ** -0.5)
    if sink is not None:
        s_sink = jnp.broadcast_to(sink.astype(F32).reshape(hkv, grp)[None, :, :, None, None], s.shape[:-1] + (1,))
        s = jnp.concatenate([s, s_sink], axis=-1)
    p = jax.nn.softmax(s, axis=-1).astype(v.dtype)[..., :nk]
    o = jnp.einsum('bhgqk,bkhd->bqhgd', p, v)
    return o.reshape(b, nq, hq * d)


def na_project(p, q_norm, k_norm):
    b, n, _ = p.shape
    q, k, v = jnp.split(p, 3, axis=-1)
    q = rms_norm(q.reshape(b, n, NA_HEADS, NA_HEAD_DIM), q_norm)
    k = rms_norm(k.reshape(b, n, NA_HEADS, NA_HEAD_DIM), k_norm)
    v = v.reshape(b, n, NA_HEADS, NA_HEAD_DIM)
    return q, k, v


def na_latent(q, k, v, k_ctx, v_ctx, rpb):
    b, n, h, d = q.shape
    rows = n // GRID_W
    kh = min(NA_KH, rows)
    ncb = GRID_W // NA_QC
    nk = kh * NA_KC
    r = jnp.arange(rows)
    row_idx = jnp.clip(r - kh // 2, 0, rows - kh)[:, None] + jnp.arange(kh)[None, :]
    cb = jnp.arange(ncb)
    col_idx = jnp.clip(cb * NA_QC - NA_KW // 2, 0, GRID_W - NA_KC)[:, None] + jnp.arange(NA_KC)[None, :]
    q_col = cb[:, None] * NA_QC + jnp.arange(NA_QC)[None, :]
    q_col0 = jnp.clip(q_col - NA_KW // 2, 0, GRID_W - NA_KW)
    col_ok = (col_idx[:, None, :] >= q_col0[:, :, None]) & (col_idx[:, None, :] < q_col0[:, :, None] + NA_KW)
    mask = jnp.broadcast_to(col_ok[:, :, None, :], (ncb, NA_QC, kh, NA_KC)).reshape(ncb, 1, NA_QC, nk)

    def gather(t):
        grid = t.reshape(b, rows, GRID_W, h, d)
        g = grid[:, row_idx[:, None, :, None], col_idx[None, :, None, :]]
        return g.reshape(b, rows, ncb, nk, h, d)

    k_nb, v_nb = gather(k), gather(v)
    q_blk = q.reshape(b, rows, ncb, NA_QC, h, d)
    scale = d ** -0.5
    dr = row_idx - r[:, None] + (NA_KH - 1)
    dc = jnp.clip(col_idx[:, None, :] - q_col[:, :, None], 1 - NA_KW, NA_KW - 1) + (NA_KW - 1)
    bias = rpb.astype(F32)[:, dr[:, None, None, :, None], dc[None, :, :, None, :]]
    bias = jnp.moveaxis(bias, 0, 2).reshape(rows, ncb, h, NA_QC, nk)
    s_loc = jnp.einsum('brcqhd,brckhd->brchqk', q_blk, k_nb, preferred_element_type=F32) * scale + bias
    s_loc = jnp.where(mask[None, None], s_loc, NEG_INF)
    s_ctx = jnp.einsum('brcqhd,bkhd->brchqk', q_blk, k_ctx, preferred_element_type=F32) * scale
    p = jax.nn.softmax(jnp.concatenate([s_loc, s_ctx], axis=-1), axis=-1).astype(v.dtype)
    o = (jnp.einsum('brchqk,brckhd->brcqhd', p[..., :nk], v_nb)
         + jnp.einsum('brchqk,bkhd->brcqhd', p[..., nk:], v_ctx))
    return o.reshape(b, n, h * d)


def conv_ffn(h, w_up, conv_w, conv_b, w_down):
    a = h @ w_up
    ap = jnp.pad(a, ((0, 0), (1, 1), (0, 0)))
    a = ap[:, :-2] * conv_w[0] + ap[:, 1:-1] * conv_w[1] + ap[:, 2:] * conv_w[2] + conv_b
    gate, val = jnp.split(a, 2, axis=-1)
    return (jax.nn.silu(gate) * val) @ w_down


def setup_inputs(seed: int = 0) -> dict:
    key = jax.random.key(seed)
    ks = jax.random.split(key, 32)
    L = DEPTH

    def nrm(k, shape, scale):
        return jax.random.normal(k, shape, F32) * scale

    def gain(k, shape):
        return 1.0 + 0.1 * jax.random.normal(k, shape, F32)

    return {
        'x': nrm(ks[0], (BATCH, SEQ, D_MODEL), 1.0),
        'c': nrm(ks[1], (BATCH, D_MODEL), 1.0),
        'ctx': nrm(ks[2], (BATCH, CTX_LEN, D_MODEL), 1.0),
        'c_ctx': nrm(ks[3], (D_MODEL,), 1.0),
        'w_mod': nrm(ks[4], (L, D_MODEL, 6 * D_MODEL), 0.5 * D_MODEL ** -0.5),
        'b_mod': nrm(ks[5], (L, 6 * D_MODEL), 0.01),
        'g_mix': gain(ks[6], (L, D_MODEL)),
        'g_ffn': gain(ks[7], (L, D_MODEL)),
        'w_in': nrm(ks[8], (L, D_MODEL, IN_COLS), D_MODEL ** -0.5),
        'w_out': nrm(ks[9], (L, MIX_OUT, D_MODEL), MIX_OUT ** -0.5),
        'mla_q_a_norm': gain(ks[10], (L, MLA_Q_LORA)),
        'mla_w_qb': nrm(ks[11], (L, MLA_Q_LORA, MLA_HEADS * (MLA_NOPE + MLA_ROPE)), MLA_Q_LORA ** -0.5),
        'mla_kv_a_norm': gain(ks[12], (L, MLA_KV_LORA)),
        'mla_w_kvb': nrm(ks[13], (L, MLA_KV_LORA, MLA_HEADS * (MLA_NOPE + MLA_V)), MLA_KV_LORA ** -0.5),
        'mla_q_nope_norm': gain(ks[14], (L, MLA_NOPE)),
        'mla_q_rope_norm': gain(ks[15], (L, MLA_ROPE)),
        'mla_k_nope_norm': gain(ks[16], (L, MLA_NOPE)),
        'mla_k_rope_norm': gain(ks[17], (L, MLA_ROPE)),
        'pool_w': nrm(ks[18], (L, len(POOL_WINDOWS), POOL_GROUP, POOL_GROUP), POOL_GROUP ** -0.5),
        'pool_scale': gain(ks[19], (L, POOL_WIDTH)),
        'swa_q_norm': gain(ks[20], (L, SWA_HEAD_DIM)),
        'swa_k_norm': gain(ks[21], (L, SWA_HEAD_DIM)),
        'swa_sink': nrm(ks[22], (L, SWA_HEADS), 0.5),
        'na_q_norm': gain(ks[23], (L, NA_HEAD_DIM)),
        'na_k_norm': gain(ks[24], (L, NA_HEAD_DIM)),
        'na_rpb': nrm(ks[25], (L, NA_HEADS, 2 * NA_KH - 1, 2 * NA_KW - 1), 0.5),
        'ffn_w_up': nrm(ks[26], (L, D_MODEL, 2 * FFN_DIM), D_MODEL ** -0.5),
        'ffn_conv_w': nrm(ks[27], (L, 3, 2 * FFN_DIM), 3 ** -0.5),
        'ffn_conv_b': nrm(ks[28], (L, 2 * FFN_DIM), 0.02),
        'ffn_w_down': nrm(ks[29], (L, FFN_DIM, D_MODEL), FFN_DIM ** -0.5),
    }


def reference(x, c, ctx, c_ctx, w_mod, b_mod, g_mix, g_ffn, w_in, w_out,
              mla_q_a_norm, mla_w_qb, mla_kv_a_norm, mla_w_kvb,
              mla_q_nope_norm, mla_q_rope_norm, mla_k_nope_norm, mla_k_rope_norm,
              pool_w, pool_scale, swa_q_norm, swa_k_norm, swa_sink,
              na_q_norm, na_k_norm, na_rpb,
              ffn_w_up, ffn_conv_w, ffn_conv_b, ffn_w_down):
    b, n, _ = x.shape
    n_ctx = ctx.shape[1]
    ang_mla = axial_angles(n, MLA_ROPE)
    ang_swa = axial_angles(n, SWA_HEAD_DIM)
    cond_x = c[:, None, :]
    for l in range(DEPTH):
        update_ctx = l < DEPTH - 1
        sh_m, sc_m, gt_m, sh_f, sc_f, gt_f = adaln(cond_x, w_mod[l], b_mod[l])
        csh_m, csc_m, cgt_m, csh_f, csc_f, cgt_f = adaln(c_ctx, w_mod[l], b_mod[l])

        px = modulate(rms_norm(x, g_mix[l]), sh_m, sc_m) @ w_in[l]
        pc = modulate(rms_norm(ctx, g_mix[l]), csh_m, csc_m) @ w_in[l]
        mla_x, pool_x, swa_x, na_x = jnp.split(px, IN_SPLITS, axis=-1)
        mla_c, pool_c, swa_c, na_c = jnp.split(pc, IN_SPLITS, axis=-1)

        mla_w = (mla_q_a_norm[l], mla_w_qb[l], mla_kv_a_norm[l], mla_w_kvb[l],
                 mla_q_nope_norm[l], mla_q_rope_norm[l], mla_k_nope_norm[l], mla_k_rope_norm[l])
        aq_n, aq_r, ak_n, ak_r, av = mla_project(mla_x, *mla_w, ang_mla)
        cq_n, cq_r, ck_n, ck_r, cv = mla_project(mla_c, *mla_w, None)
        attend_all = functools.partial(
            mla_attend,
            k_nope=jnp.concatenate([ak_n, ck_n], axis=1),
            k_rope=jnp.concatenate([ak_r, ck_r], axis=1),
            v=jnp.concatenate([av, cv], axis=1))
        out_a = map_query_blocks(attend_all, (aq_n, aq_r)).reshape(b, n, MLA_HEADS * MLA_V)

        out_b = pool_mixer(pool_x, pool_w[l], pool_scale[l])

        sq, sk, sv = swa_project(swa_x, swa_q_norm[l], swa_k_norm[l], ang_swa)
        csq, csk, csv = swa_project(swa_c, swa_q_norm[l], swa_k_norm[l], None)
        out_c = swa_latent(sq, sk, sv, csk, csv, swa_sink[l])

        nq, nkk, nv = na_project(na_x, na_q_norm[l], na_k_norm[l])
        cnq, cnk, cnv = na_project(na_c, na_q_norm[l], na_k_norm[l])
        out_d = na_latent(nq, nkk, nv, cnk, cnv, na_rpb[l])

        if update_ctx:
            mix_c = jnp.concatenate([
                mla_attend(cq_n, cq_r, ck_n, ck_r, cv).reshape(b, n_ctx, MLA_HEADS * MLA_V),
                pool_mixer(pool_c, pool_w[l], pool_scale[l]),
                ctx_attention(csq, csk, csv, swa_sink[l]),
                ctx_attention(cnq, cnk, cnv, None),
            ], axis=-1)
            ctx = ctx + cgt_m * (mix_c @ w_out[l])
            ctx = ctx + cgt_f * conv_ffn(modulate(rms_norm(ctx, g_ffn[l]), csh_f, csc_f),
                                         ffn_w_up[l], ffn_conv_w[l], ffn_conv_b[l], ffn_w_down[l])

        mix_x = jnp.concatenate([out_a, out_b, out_c, out_d], axis=-1)
        x = x + gt_m * (mix_x @ w_out[l])
        x = x + gt_f * conv_ffn(modulate(rms_norm(x, g_ffn[l]), sh_f, sc_f),
                                ffn_w_up[l], ffn_conv_w[l], ffn_conv_b[l], ffn_w_down[l])
    return x
```

```cpp
#include <hip/hip_runtime.h>
#include <cstdio>
#include <cstdint>

#define DI __device__ __forceinline__
#define GAS __attribute__((address_space(1)))
#define LAS __attribute__((address_space(3)))
typedef unsigned short bf16;
typedef unsigned v4u __attribute__((ext_vector_type(4)));
typedef unsigned v2u __attribute__((ext_vector_type(2)));
typedef float f32x4 __attribute__((ext_vector_type(4)));
typedef float f32x2 __attribute__((ext_vector_type(2)));
typedef float f32x16 __attribute__((ext_vector_type(16)));
typedef short bf16x8 __attribute__((ext_vector_type(8)));
typedef short s16x4 __attribute__((ext_vector_type(4)));
typedef GAS unsigned gu32;
#define RLX_AGENT __ATOMIC_RELAXED, __HIP_MEMORY_SCOPE_AGENT
#define LDS_WAIT() asm volatile("s_waitcnt lgkmcnt(0)" ::: "memory")
#define VM_WAIT() asm volatile("s_waitcnt vmcnt(0)" ::: "memory")
DI int fresh_lane() { int l; asm volatile("v_mbcnt_lo_u32_b32 %0, -1, 0\n\tv_mbcnt_hi_u32_b32 %0, -1, %0" : "=v"(l)); return l; }
DI unsigned f2bf(float f) { unsigned u = __builtin_bit_cast(unsigned, f); return (u + 0x7fffu + ((u >> 16) & 1u)) >> 16; }
DI unsigned pk2(float lo, float hi) { return f2bf(lo) | (f2bf(hi) << 16); }
DI float bf2f(unsigned short b) { return __builtin_bit_cast(float, (unsigned)b << 16); }
DI float bflo(unsigned w) { return __builtin_bit_cast(float, w << 16); }
DI float bfhi(unsigned w) { return __builtin_bit_cast(float, w & 0xffff0000u); }

namespace pg8 {
#define PG8_LAS __attribute__((address_space(3)))
typedef unsigned short bf16_t;
typedef short bf16x8 __attribute__((ext_vector_type(8)));
typedef float f32x4 __attribute__((ext_vector_type(4)));
typedef unsigned u32x4 __attribute__((ext_vector_type(4)));
constexpr int BM = 256, BK = 64, HALF = 128, HTB = HALF * BK * 2  , STAGE_BYTES = 8 * HTB, NXCD = 8, WGM = 8;

__host__ __device__ __forceinline__ int lds_byte(int r, int c) { const int st = (r >> 4) * 2 + (c >> 5), rr = r & 15, cc = c & 31, ob = rr * 64 + cc * 2; return st * 1024 + (ob ^ (((ob >> 9) & 1) << 5)); }
__host__ __device__ __forceinline__ void stage_rc(int b, int& R, int& C) { const int st = b / 1024, sb = b % 1024, swz = sb ^ (((sb >> 9) & 1) << 5); R = (st >> 1) * 16 + swz / 64; C = (st & 1) * 32 + (swz % 64) / 2; }
__host__ __device__ __forceinline__ int perm32(int rho) { const int n = rho >> 4, i = rho & 15; return 8 * (i >> 2) + 4 * n + (i & 3); }

struct Unit { int pm, pn, pk; };
struct Gemm { const bf16_t* A; const bf16_t* Bt; int M, N, K, ld; };

struct StaticOrder {
    int nM, nN, nwg, G, c;
    __host__ __device__ void init(int M, int N, int G_, int c_) { nM = M / BM; nN = N / BM; nwg = nM * nN; G = G_; c = c_; }
    __host__ __device__ bool next(int i, Unit& u) const {
        const long L = (long)i * G + c; if (L >= nwg) return false;
        int wgid = (int)L; { const int q = nwg / NXCD, r = nwg % NXCD, xcd = wgid % NXCD, off = wgid / NXCD; wgid = (xcd < r ? xcd * (q + 1) : r * (q + 1) + (xcd - r) * q) + off; }
        const int nig = WGM * nN, gid = wgid / nig, fm = gid * WGM, gsz = (nM - fm) < WGM ? (nM - fm) : WGM;
        u.pm = fm + ((wgid % nig) % gsz); u.pn = (wgid % nig) / gsz; u.pk = 0; return true;
    }
    __device__ __forceinline__ void a_ready(const Unit&) const {}
    __device__ __forceinline__ void done(const Unit&) const {}
};

__device__ __forceinline__ unsigned cvt_pk_bf16(float lo, float hi) { unsigned r; asm volatile("v_cvt_pk_bf16_f32 %0, %1, %2" : "=v"(r) : "v"(lo), "v"(hi)); return r; }
typedef float f32x2 __attribute__((ext_vector_type(2)));
struct EpiBf16S {
    static constexpr bool PERM = true, AFTER_DRAIN = false, PERMA = false;
    bf16_t* O; int ldc; int coff; const float* cscale;
    __device__ __forceinline__ void operator()(const f32x4 (&acc)[2][2][4][2], const Unit& u, int wr, int wc, int fr, int fq) const {
        const int row0 = u.pm * BM + wr * 64 + fr; const int col0 = u.pn * BM + wc * 32 + 8 * fq;
        f32x4 sv[2][2];
#pragma unroll
        for (int bj = 0; bj < 2; ++bj)
#pragma unroll
            for (int n = 0; n < 2; ++n) sv[bj][n] = cscale ? *(const f32x4*)(cscale + col0 + bj * HALF + 4 * n) : (f32x4){1.f, 1.f, 1.f, 1.f};
#pragma unroll
        for (int ai = 0; ai < 2; ++ai)
#pragma unroll
            for (int m = 0; m < 4; ++m) { bf16_t* rowp = O + (size_t)(row0 + ai * HALF + m * 16) * ldc + coff + col0;
#pragma unroll
                for (int bj = 0; bj < 2; ++bj) { const f32x4 v0 = acc[ai][bj][m][0] * sv[bj][0], v1 = acc[ai][bj][m][1] * sv[bj][1];
                    u32x4 w; w.x = cvt_pk_bf16(v0[0], v0[1]); w.y = cvt_pk_bf16(v0[2], v0[3]); w.z = cvt_pk_bf16(v1[0], v1[1]); w.w = cvt_pk_bf16(v1[2], v1[3]);
                    *(u32x4*)(rowp + bj * HALF) = w; } }
    }
};
struct EpiResid {
    static constexpr bool PERM = false, AFTER_DRAIN = false, PERMA = false;
    const float* blat; const float* bctx; float* olat; float* octx; const float* gate;
    __device__ __forceinline__ void operator()(const f32x4 (&acc)[2][2][4][2], const Unit& u, int wr, int wc, int fr, int fq) const {
        const int row0 = u.pm * BM + wr * 64 + fr, col0 = u.pn * BM + wc * 32 + 4 * fq;
        const int bid = u.pm < 16 ? 0 : (u.pm < 32 ? 1 : 2);
        const float* gp = gate + (size_t)bid * 12288 + col0;
        const float* bs = u.pm < 32 ? blat : bctx - (size_t)8192 * 2048;
        float* os = u.pm < 32 ? olat : octx - (size_t)8192 * 2048;
        f32x4 gv[2][2];
#pragma unroll
        for (int bj = 0; bj < 2; ++bj)
#pragma unroll
            for (int n = 0; n < 2; ++n) gv[bj][n] = *(const f32x4*)(gp + bj * HALF + n * 16);
#pragma unroll
        for (int ai = 0; ai < 2; ++ai)
#pragma unroll
            for (int m = 0; m < 4; ++m) { const size_t ro = (size_t)(row0 + ai * HALF + m * 16) * 2048 + col0;
                if (m & 1) asm volatile("" ::: "memory");
#pragma unroll
                for (int bj = 0; bj < 2; ++bj)
#pragma unroll
                    for (int n = 0; n < 2; ++n) { const f32x4 b = *(const f32x4*)(bs + ro + bj * HALF + n * 16);
                        *(f32x4*)(os + ro + bj * HALF + n * 16) = b + gv[bj][n] * acc[ai][bj][m][n]; } }
    }
};
struct SplitOrder {
    int pm0, nM, nN, nS, G, c;
    __device__ bool next(int i, Unit& u) const { const long L = (long)i * G + c; if (L >= (long)nM * nN * nS) return false; const int q = (int)L;
        u.pk = q % nS; u.pn = (q / nS) % nN; u.pm = pm0 + q / (nS * nN); return true; }
    __device__ __forceinline__ void a_ready(const Unit&) const {}
    __device__ __forceinline__ void done(const Unit&) const {}
};
struct EpiSlab {
    static constexpr bool PERM = false, AFTER_DRAIN = false, PERMA = false;
    float* slab; int pm0, nrows, ldc;
    __device__ __forceinline__ void operator()(const f32x4 (&acc)[2][2][4][2], const Unit& u, int wr, int wc, int fr, int fq) const {
        const int row0 = (u.pm - pm0) * BM + wr * 64 + fr, col0 = u.pn * BM + wc * 32 + 4 * fq;
        float* base = slab + (size_t)u.pk * nrows * ldc;
#pragma unroll
        for (int ai = 0; ai < 2; ++ai)
#pragma unroll
            for (int m = 0; m < 4; ++m) { float* rowp = base + (size_t)(row0 + ai * HALF + m * 16) * ldc + col0;
#pragma unroll
                for (int bj = 0; bj < 2; ++bj)
#pragma unroll
                    for (int n = 0; n < 2; ++n) *(f32x4*)(rowp + bj * HALF + n * 16) = acc[ai][bj][m][n]; }
    }
};
template <int CTRL> __device__ __forceinline__ float dpp_ror(float x) { return __builtin_bit_cast(float, __builtin_amdgcn_update_dpp(0, __builtin_bit_cast(int, x), CTRL, 0xf, 0xf, false)); }
struct EpiConvGate {
    static constexpr bool PERM = true, AFTER_DRAIN = false, PERMA = true;
    bf16_t* G; float* RAW; const float* cw; const float* cb; PG8_LAS float* XB;
    __device__ __forceinline__ void operator()(const f32x4 (&acc)[2][2][4][2], const Unit& u, int wr, int wc, int fr, int fq) const {
        const int lane = fq * 16 + fr, wid = wr * 4 + wc;
        const int gcol = u.pn * 128 + wc * 32 + 8 * fq;
        float wv[2];
        { const int t = wid * 64 + lane;
#pragma unroll
          for (int q = 0; q < 2; ++q) { const int e = t + 512 * q, k = e >> 8, c = e & 255; const int oc = (c >> 7) * 5632 + u.pn * 128 + (c & 127);
              wv[q] = k < 3 ? cw[(size_t)k * 11264 + oc] : cb[oc]; } }
        if (fr == 0 || fr == 15) { const int e = fr == 0 ? 0 : 1, m = fr == 0 ? 0 : 3;
#pragma unroll
            for (int ai = 0; ai < 2; ++ai) { PG8_LAS float* p = XB + ((wid * 2 + ai) * 2 + e) * 64 + fq * 16;
#pragma unroll
                for (int bj = 0; bj < 2; ++bj)
#pragma unroll
                    for (int n = 0; n < 2; ++n) *(PG8_LAS f32x4*)(p + bj * 8 + n * 4) = (m == 0 ? acc[ai][bj][0][n] : acc[ai][bj][3][n]); } }
        { PG8_LAS float* WL = XB + 2048; const int t = wid * 64 + lane; WL[t] = wv[0]; WL[t + 512] = wv[1]; }
        asm volatile("s_waitcnt vmcnt(0) lgkmcnt(0)\n\ts_barrier" ::: "memory");
        { const bool top = (wr == 0) && (fr == 0), bot = (wr == 1) && (fr == 15);
          if (top || bot) { float* rp = RAW + ((size_t)u.pm * 4 + (top ? 0 : 2)) * 11264 + gcol;
#pragma unroll
              for (int bj = 0; bj < 2; ++bj)
#pragma unroll
                  for (int n = 0; n < 2; ++n) { *(f32x4*)(rp + bj * 5632 + n * 4) = (top ? acc[0][bj][0][n] : acc[1][bj][2][n]);
                                                *(f32x4*)(rp + 11264 + bj * 5632 + n * 4) = (top ? acc[0][bj][1][n] : acc[1][bj][3][n]); } } }
#pragma unroll
        for (int n = 0; n < 2; ++n) {
#pragma unroll
            for (int ai = 0; ai < 2; ++ai) {
                asm volatile("" ::: "memory");
                const PG8_LAS float* wl = XB + 2048 + wc * 32 + 8 * fq + 4 * n;
                const bool has_up = !(wr == 0 && ai == 0), has_dn = !(wr == 1 && ai == 1);
                const int w_up = wr == 1 ? wc : 4 + wc, a_up = wr == 1 ? ai : ai - 1, w_dn = wr == 0 ? 4 + wc : wc, a_dn = wr == 0 ? ai : ai + 1;
                const PG8_LAS float* pu = XB + ((w_up * 2 + a_up) * 2 + 1) * 64 + fq * 16 + n * 4;
                const PG8_LAS float* pd = XB + ((w_dn * 2 + a_dn) * 2 + 0) * 64 + fq * 16 + n * 4;
                f32x4 sg[4];
                { const f32x4 w0 = *(const PG8_LAS f32x4*)wl, w1 = *(const PG8_LAS f32x4*)(wl + 256), w2 = *(const PG8_LAS f32x4*)(wl + 512), bb = *(const PG8_LAS f32x4*)(wl + 768);
                  f32x4 hu = {0.f, 0.f, 0.f, 0.f}, hd = hu;
                  if (has_up) hu = *(const PG8_LAS f32x4*)pu;
                  if (has_dn) hd = *(const PG8_LAS f32x4*)pd;
                  f32x4 p0, n3;
#pragma unroll
                  for (int j = 0; j < 4; ++j) { const float t = dpp_ror<0x121>(acc[ai][0][3][n][j]), d = dpp_ror<0x12F>(acc[ai][0][0][n][j]); p0[j] = fr == 0 ? hu[j] : t; n3[j] = fr == 15 ? hd[j] : d; }
#pragma unroll
                  for (int m = 0; m < 4; ++m) {
                      const f32x4 pr = m == 0 ? p0 : acc[ai][0][m > 0 ? m - 1 : 0][n], nx = m == 3 ? n3 : acc[ai][0][m < 3 ? m + 1 : 3][n];
                      const f32x4 gg = pr * w0 + acc[ai][0][m][n] * w1 + nx * w2 + bb;
#pragma unroll
                      for (int j = 0; j < 4; ++j) sg[m][j] = gg[j] * __builtin_amdgcn_rcpf(1.0f + __builtin_amdgcn_exp2f(gg[j] * -1.4426950408889634f));
                  } }
                __builtin_amdgcn_sched_barrier(0);
                { const f32x4 w0 = *(const PG8_LAS f32x4*)(wl + 128), w1 = *(const PG8_LAS f32x4*)(wl + 256 + 128), w2 = *(const PG8_LAS f32x4*)(wl + 512 + 128), bb = *(const PG8_LAS f32x4*)(wl + 768 + 128);
                  f32x4 hu = {0.f, 0.f, 0.f, 0.f}, hd = hu;
                  if (has_up) hu = *(const PG8_LAS f32x4*)(pu + 8);
                  if (has_dn) hd = *(const PG8_LAS f32x4*)(pd + 8);
                  f32x4 p0, n3;
#pragma unroll
                  for (int j = 0; j < 4; ++j) { const float t = dpp_ror<0x121>(acc[ai][1][3][n][j]), d = dpp_ror<0x12F>(acc[ai][1][0][n][j]); p0[j] = fr == 0 ? hu[j] : t; n3[j] = fr == 15 ? hd[j] : d; }
#pragma unroll
                  for (int m = 0; m < 4; ++m) {
                      asm volatile("" ::: "memory");
                      const f32x4 pr = m == 0 ? p0 : acc[ai][1][m > 0 ? m - 1 : 0][n], nx = m == 3 ? n3 : acc[ai][1][m < 3 ? m + 1 : 3][n];
                      const f32x4 o = (pr * w0 + acc[ai][1][m][n] * w1 + nx * w2 + bb) * sg[m];
                      const int trow = ai * HALF + wr * 64 + fr * 4 + m;
                      if (trow != 0 && trow != 255) { typedef unsigned u32x2 __attribute__((ext_vector_type(2))); u32x2 w; w.x = cvt_pk_bf16(o[0], o[1]); w.y = cvt_pk_bf16(o[2], o[3]);
                          *(u32x2*)(G + (size_t)(u.pm * BM + trow) * 5632 + gcol + 4 * n) = w; }
                  } }
            }
        }
    }
};
template <class Epi, class Sched, bool ALIGN_EPI = false, bool SP2 = false>
__device__ __forceinline__ void gemm_phase(PG8_LAS unsigned char* lds, const Gemm g, const Sched& S, const Epi& E, const int wave0) {
    const int tid_ = wave0 * 64 + fresh_lane();
    const int tid = tid_, wid = __builtin_amdgcn_readfirstlane(tid >> 6), lane = tid & 63, wr = wid >> 2, wc = wid & 3, fr = lane & 15, fq = lane >> 4;
    const int K = g.ld, nt = g.K / BK;
    unsigned voffA[2], voffB[2];
#pragma unroll
    for (int i = 0; i < 2; ++i) { int R, C; stage_rc(tid * 16 + i * 8192, R, C); const int Rb = Epi::PERM ? ((R & ~31) + perm32(R & 31)) : R;
        const int Ra = Epi::PERMA ? ((R & ~63) + (R & 15) * 4 + ((R >> 4) & 3)) : R;
        voffA[i] = (unsigned)(Ra * K + C) * 2u; voffB[i] = (unsigned)(Rb * K + C) * 2u; }
    const size_t kstep = (size_t)(BK * 2);
    const size_t hstep = (size_t)HALF * K * 2;
    const size_t tstep = 2 * hstep;
    const unsigned ldsw = (unsigned)wid * 1024u;
    const int aoff = lds_byte(wr * 64 + fr, fq * 8), boff = lds_byte(wc * 32 + fr, fq * 8);
#define PG8_SA(b, h) (((b) * 2 + (h)) * HTB)
#define PG8_SB(b, h) ((4 + (b) * 2 + (h)) * HTB)
#define PG8_STAGE(bufoff, gbase, voff) do { _Pragma("unroll") for (int _i = 0; _i < 2; ++_i) \
        __builtin_amdgcn_global_load_lds((const unsigned*)((const char*)(gbase) + (voff)[_i]), (PG8_LAS unsigned*)(lds + (bufoff) + ldsw + _i * 8192), 16, 0, 0); } while (0)
#define PG8_LDA(dst, b, h) do { _Pragma("unroll") for (int m = 0; m < 4; ++m) _Pragma("unroll") for (int k = 0; k < 2; ++k) dst[m][k] = *(const PG8_LAS bf16x8*)(lds + PG8_SA(b, h) + aoff + m * 2048 + k * 1024); } while (0)
#define PG8_LDB(dst, b, h) do { _Pragma("unroll") for (int n = 0; n < 2; ++n) _Pragma("unroll") for (int k = 0; k < 2; ++k) dst[n][k] = *(const PG8_LAS bf16x8*)(lds + PG8_SB(b, h) + boff + n * 2048 + k * 1024); } while (0)
#define PG8_MMA(ai, bj, At, Bt) do { __builtin_amdgcn_s_setprio(1); _Pragma("unroll") for (int m = 0; m < 4; ++m) _Pragma("unroll") for (int n = 0; n < 2; ++n) _Pragma("unroll") for (int k = 0; k < 2; ++k) \
        acc[ai][bj][m][n] = __builtin_amdgcn_mfma_f32_16x16x32_bf16(Bt[n][k], At[m][k], acc[ai][bj][m][n], 0, 0, 0); __builtin_amdgcn_s_setprio(0); } while (0)
#define PG8_WAIT_V(n) asm volatile("s_waitcnt vmcnt(" #n ")" ::: "memory")
#define PG8_WAIT_L(n) asm volatile("s_waitcnt lgkmcnt(" #n ")" ::: "memory")
#define PG8_BAR __builtin_amdgcn_s_barrier()
#define PG8_SCHED __builtin_amdgcn_sched_barrier(0)
    Unit cur, nxt; int ui = 0;
    if (!S.next(0, cur)) return;
    f32x4 acc[2][2][4][2];
#pragma unroll
    for (int a = 0; a < 2; ++a)
#pragma unroll
        for (int b = 0; b < 2; ++b)
#pragma unroll
            for (int m = 0; m < 4; ++m)
#pragma unroll
                for (int n = 0; n < 2; ++n) acc[a][b][m][n] = (f32x4){0.f, 0.f, 0.f, 0.f};
    bf16x8 At[4][2], B0[2][2], B1[2][2];
    const char* cA = (const char*)g.A + (size_t)cur.pm * tstep + (size_t)cur.pk * g.K * 2; const char* cB = (const char*)g.Bt + (size_t)cur.pn * tstep + (size_t)cur.pk * g.K * 2;
    S.a_ready(cur);
    if constexpr (SP2) {
        PG8_STAGE(PG8_SB(0, 0), cB, voffB); PG8_STAGE(PG8_SB(0, 1), cB + hstep, voffB); PG8_STAGE(PG8_SA(0, 0), cA, voffA); PG8_STAGE(PG8_SA(0, 1), cA + hstep, voffA);
        if (wr == 1) PG8_BAR;
        PG8_WAIT_V(2); PG8_BAR;
        PG8_STAGE(PG8_SB(1, 0), cB + kstep, voffB); PG8_STAGE(PG8_SA(1, 0), cA + kstep, voffA); PG8_STAGE(PG8_SB(1, 1), cB + hstep + kstep, voffB);
        PG8_WAIT_V(6); PG8_BAR;
    } else {
        PG8_STAGE(PG8_SB(0, 0), cB, voffB); PG8_STAGE(PG8_SA(0, 0), cA, voffA); PG8_STAGE(PG8_SB(0, 1), cB + hstep, voffB); PG8_STAGE(PG8_SA(0, 1), cA + hstep, voffA);
        if (wr == 1) PG8_BAR;
        PG8_WAIT_V(4); PG8_BAR;
        PG8_STAGE(PG8_SB(1, 0), cB + kstep, voffB); PG8_STAGE(PG8_SA(1, 0), cA + kstep, voffA); PG8_STAGE(PG8_SB(1, 1), cB + hstep + kstep, voffB);
        PG8_WAIT_V(6); PG8_BAR;
    }
    for (;;) {
        const bool has_next = S.next(ui + 1, nxt);
        const char* nA = has_next ? (const char*)g.A + (size_t)nxt.pm * tstep + (size_t)nxt.pk * g.K * 2 : cA; const char* nB = has_next ? (const char*)g.Bt + (size_t)nxt.pn * tstep + (size_t)nxt.pk * g.K * 2 : cB;
        for (int t = 0; t < nt; t += 2) {
            const bool last = (t == nt - 2);
            const char* a1 = cA + (size_t)(t + 1) * kstep;
            const char* a2 = last ? nA : cA + (size_t)(t + 2) * kstep; const char* b2 = last ? nB : cB + (size_t)(t + 2) * kstep;
            const char* a3 = a2 + kstep; const char* b3 = b2 + kstep;
            if (last && has_next) S.a_ready(nxt);
            if constexpr (SP2) {
            PG8_LDB(B0, 0, 0); PG8_LDB(B1, 0, 1); PG8_SCHED; PG8_LDA(At, 0, 0); PG8_STAGE(PG8_SA(1, 1), a1 + hstep, voffA);
            PG8_WAIT_V(8); PG8_WAIT_L(0); PG8_BAR; PG8_MMA(0, 0, At, B0); PG8_MMA(0, 1, At, B1); PG8_BAR; PG8_SCHED;
            PG8_LDA(At, 0, 1); PG8_STAGE(PG8_SB(0, 0), b2, voffB); PG8_STAGE(PG8_SB(0, 1), b2 + hstep, voffB); PG8_STAGE(PG8_SA(0, 0), a2, voffA);
            PG8_WAIT_V(8); PG8_WAIT_L(0); PG8_BAR; PG8_MMA(1, 0, At, B0); PG8_MMA(1, 1, At, B1); PG8_BAR; PG8_SCHED;
            PG8_LDB(B0, 1, 0); PG8_LDB(B1, 1, 1); PG8_SCHED; PG8_LDA(At, 1, 0); PG8_STAGE(PG8_SA(0, 1), a2 + hstep, voffA);
            PG8_WAIT_V(8); PG8_WAIT_L(0); PG8_BAR; PG8_MMA(0, 0, At, B0); PG8_MMA(0, 1, At, B1); PG8_BAR; PG8_SCHED;
            PG8_LDA(At, 1, 1); PG8_STAGE(PG8_SB(1, 0), b3, voffB); PG8_STAGE(PG8_SB(1, 1), b3 + hstep, voffB); PG8_STAGE(PG8_SA(1, 0), a3, voffA);
            PG8_WAIT_V(8); PG8_WAIT_L(0); PG8_BAR; PG8_MMA(1, 0, At, B0); PG8_MMA(1, 1, At, B1); PG8_BAR; PG8_SCHED;
            } else {
            PG8_LDB(B0, 0, 0); PG8_SCHED; PG8_LDA(At, 0, 0); PG8_STAGE(PG8_SA(1, 1), a1 + hstep, voffA);
            PG8_WAIT_L(8); PG8_BAR; PG8_WAIT_L(0); PG8_MMA(0, 0, At, B0); PG8_BAR; PG8_SCHED;
            PG8_LDB(B1, 0, 1); PG8_STAGE(PG8_SB(0, 0), b2, voffB);
            PG8_BAR; PG8_WAIT_L(0); PG8_MMA(0, 1, At, B1); PG8_BAR;
            PG8_LDA(At, 0, 1); PG8_STAGE(PG8_SA(0, 0), a2, voffA);
            PG8_BAR; PG8_WAIT_L(0); PG8_MMA(1, 0, At, B0); PG8_BAR; PG8_SCHED;
            PG8_STAGE(PG8_SB(0, 1), b2 + hstep, voffB);
            PG8_WAIT_V(6); PG8_BAR; PG8_MMA(1, 1, At, B1); PG8_BAR;
            PG8_LDB(B0, 1, 0); PG8_SCHED; PG8_LDA(At, 1, 0); PG8_STAGE(PG8_SA(0, 1), a2 + hstep, voffA);
            PG8_WAIT_L(8); PG8_BAR; PG8_WAIT_L(0); PG8_MMA(0, 0, At, B0); PG8_BAR; PG8_SCHED;
            PG8_LDB(B1, 1, 1); PG8_STAGE(PG8_SB(1, 0), b3, voffB);
            PG8_BAR; PG8_WAIT_L(0); PG8_MMA(0, 1, At, B1); PG8_BAR;
            PG8_LDA(At, 1, 1); PG8_STAGE(PG8_SA(1, 0), a3, voffA);
            PG8_BAR; PG8_WAIT_L(0); PG8_MMA(1, 0, At, B0); PG8_BAR; PG8_SCHED;
            PG8_STAGE(PG8_SB(1, 1), b3 + hstep, voffB);
            PG8_WAIT_V(6); PG8_BAR; PG8_MMA(1, 1, At, B1); PG8_BAR;
            }
        }
        if constexpr (ALIGN_EPI) { if (wr == 0) PG8_BAR; }
        if constexpr (!Epi::AFTER_DRAIN) { E(acc, cur, wr, wc, fr, fq); S.done(cur); }
        if (!has_next) break;
#pragma unroll
        for (int a = 0; a < 2; ++a)
#pragma unroll
            for (int b = 0; b < 2; ++b)
#pragma unroll
                for (int m = 0; m < 4; ++m)
#pragma unroll
                    for (int n = 0; n < 2; ++n) acc[a][b][m][n] = (f32x4){0.f, 0.f, 0.f, 0.f};
        cur = nxt; cA = nA; cB = nB; ++ui;
        if constexpr (ALIGN_EPI) { if (wr == 1) PG8_BAR; }
    }
    PG8_WAIT_V(0);
    if constexpr (!ALIGN_EPI) { if (wr == 0) PG8_BAR; }
    PG8_BAR;
    if constexpr (Epi::AFTER_DRAIN) { E.fused(acc, cur, wr, wc, fr, fq, lds, wid, lane); S.done(cur); }
#undef PG8_SA
#undef PG8_SB
#undef PG8_STAGE
#undef PG8_LDA
#undef PG8_LDB
#undef PG8_MMA
#undef PG8_WAIT_V
#undef PG8_WAIT_L
#undef PG8_BAR
#undef PG8_SCHED
}
}
#define XB_TMO      128
#define XB_XCNT(j)  (256  + 64 * (j))
#define XB_XSUB(j)  (1280 + 64 * (j))
#define XB_XGEN(j)  (2304 + 64 * (j))
#define XB_TOP      3328
#define XB_TOPGEN   3392
#define XCD_BAR_WORDS 3456
#define XB_SPIN_CAP (1u << 18)

__device__ __forceinline__ unsigned xb_ld(unsigned* p)              { return __hip_atomic_load(p, __ATOMIC_RELAXED, __HIP_MEMORY_SCOPE_AGENT); }
__device__ __forceinline__ unsigned xb_add(unsigned* p, unsigned v) { return __hip_atomic_fetch_add(p, v, __ATOMIC_RELAXED, __HIP_MEMORY_SCOPE_AGENT); }
__device__ __forceinline__ unsigned xb_xcc_id() { return (unsigned)__builtin_amdgcn_s_getreg((3 << 11) | 20) & 0xFu; }
#define XB_SPIN(cond, bar) do { unsigned _sp = 0; while (cond) { __builtin_amdgcn_s_sleep(1); \
    if ((++_sp & 255u) == 0u) { if (xb_ld(&(bar)[XB_TMO])) break; if (_sp > XB_SPIN_CAP) { atomicAdd(&(bar)[XB_TMO], 1u); break; } } } } while (0)

struct XcdBarrier {
    unsigned* bar; unsigned x; int w0;
    volatile LAS unsigned* st;
};

__device__ __forceinline__ XcdBarrier xcd_barrier_post(unsigned* bar, volatile LAS unsigned* st, int w0) {
    XcdBarrier b; b.bar = bar; b.x = xb_xcc_id(); b.st = st; b.w0 = w0;
    if (w0 == 0 && fresh_lane() == 0) (void)xb_add(&bar[XB_XCNT(b.x)], 1u);
    return b;
}
__device__ __forceinline__ void xcd_barrier_complete(unsigned* bar, unsigned x, unsigned& nloc, unsigned& nx) {
    const unsigned G = gridDim.x * gridDim.y * gridDim.z;
    unsigned sum, cnt, mine, sp = 0u;
    for (;;) {
        sum = 0u; cnt = 0u; mine = 0u;
#pragma unroll
        for (unsigned j = 0; j < 16; ++j) { const unsigned c = xb_ld(&bar[XB_XCNT(j)]); sum += c; cnt += (c > 0u) ? 1u : 0u; mine = (j == x) ? c : mine; }
        if (sum == G) break;
        __builtin_amdgcn_s_sleep(1);
        if ((++sp & 255u) == 0u) { if (xb_ld(&bar[XB_TMO])) break; if (sp > XB_SPIN_CAP) { atomicAdd(&bar[XB_TMO], 1u); break; } }
    }
    nloc = mine > 0u ? mine : 1u; nx = cnt > 0u ? cnt : 1u;
}

__device__ __forceinline__ void xcd_barrier(const XcdBarrier& b) {
    asm volatile("s_waitcnt vmcnt(0)" ::: "memory");
    __syncthreads();
    if (b.w0 == 0 && fresh_lane() == 0) {
        unsigned* bar = b.bar;
        __builtin_amdgcn_s_waitcnt(0);
        unsigned nloc = b.st[0], nx = b.st[1];
        if (nloc == 0u) { xcd_barrier_complete(bar, b.x, nloc, nx); b.st[0] = nloc; b.st[1] = nx; }
        const unsigned old = xb_add(&bar[XB_XSUB(b.x)], 1u);
        const unsigned gen = old / nloc;
        if (old + 1u == (gen + 1u) * nloc) {
            __builtin_amdgcn_fence(__ATOMIC_RELEASE, "agent");
            asm volatile("s_waitcnt vmcnt(0)" ::: "memory");
            const unsigned og = xb_add(&bar[XB_TOP], 1u);
            const unsigned tg = og / nx;
            if (og + 1u == (tg + 1u) * nx) xb_add(&bar[XB_TOPGEN], 1u);
            else XB_SPIN(xb_ld(&bar[XB_TOPGEN]) == tg, bar);
            __builtin_amdgcn_fence(__ATOMIC_ACQUIRE, "agent");
            xb_add(&bar[XB_XGEN(b.x)], 1u);
            asm volatile("s_waitcnt vmcnt(0)" ::: "memory");
        } else {
            XB_SPIN(xb_ld(&bar[XB_XGEN(b.x)]) == gen, bar);
            __builtin_amdgcn_fence(__ATOMIC_ACQUIRE, "agent");
            asm volatile("s_waitcnt vmcnt(0)" ::: "memory");
        }
    }
    __syncthreads();
}
constexpr int DM = 2048, NBATCH = 2, SEQ = 4096, DEPTH = 4, CTXL = 256;
constexpr int NLAT = NBATCH * SEQ, NCTX = NBATCH * CTXL, NROW = NLAT + NCTX;
constexpr int NKEY = SEQ + CTXL;
constexpr int INC = 3648, INP = 3840;
constexpr int FF = 5632, FF2 = 2 * FF;
constexpr int C_CQ = 0, C_CKV = 512, C_KR = 768, C_POOL = 832, C_SQ = 1344, C_SK = 1856, C_SV = 1984, C_NQ = 2112, C_NK = 2624, C_NV = 3136;
constexpr float EPS = 1e-6f;
constexpr float LOG2E = 1.4426950408889634f;
constexpr int NWAVES = 8, NTHREADS = 512;
enum { I_X = 0, I_C, I_CTX, I_CCTX, I_WMOD, I_BMOD, I_GMIX, I_GFFN, I_WIN, I_WOUT, I_QAN, I_WQB, I_KVAN, I_WKVB, I_QNN, I_QRN, I_KNN, I_KRN,
       I_POOLW, I_POOLS, I_SQN, I_SKN, I_SINK, I_NQN, I_NKN, I_RPB, I_WUP, I_CONVW, I_CONVB, I_WDN, N_IN };

constexpr size_t MiB = 1u << 20;
constexpr size_t WS_CTL = 0, CTL_ZERO_BYTES = 64 * 1024;
constexpr size_t WS_MOD = 1 * MiB;
constexpr size_t WS_ROPE = WS_MOD + 640 * 1024;
constexpr size_t WS_WIN = 2 * MiB;
constexpr size_t WS_WOUT = 62 * MiB;
constexpr size_t WS_WUP = 94 * MiB;
constexpr size_t WS_WDN = 270 * MiB;
constexpr size_t WS_WQB = 358 * MiB;
constexpr size_t WS_WKVB = 361 * MiB;
constexpr size_t WS_WPOOL = 363 * MiB;
constexpr size_t WS_X = 365 * MiB;
constexpr size_t WS_H = 433 * MiB;
constexpr size_t WS_P = 467 * MiB;
constexpr size_t WS_MIX = 531 * MiB;
constexpr size_t WS_QN = 565 * MiB;
constexpr size_t WS_KVN = 574 * MiB;
constexpr size_t WS_POOLD = 579 * MiB;
constexpr size_t WS_WOP = WS_POOLD;
constexpr size_t WS_QRAW = 588 * MiB;
constexpr size_t WS_KVRAW = 601 * MiB;
constexpr size_t WS_QMLA = 618 * MiB;
constexpr size_t WS_KMLA = 631 * MiB;
constexpr size_t WS_VTMLA = 644 * MiB;
constexpr size_t WS_QSWA = 653 * MiB;
constexpr size_t WS_KSWA = 662 * MiB;
constexpr size_t WS_VTSWA = 665 * MiB;
constexpr size_t WS_QNA = 668 * MiB;
constexpr size_t WS_KNA = 677 * MiB;
constexpr size_t WS_VTNA = 686 * MiB;
constexpr size_t WS_AUP = 695 * MiB;
constexpr size_t WS_RAW = 823 * MiB;
constexpr size_t WS_G = 882 * MiB;
constexpr size_t WS_SLAB = 976 * MiB;
constexpr size_t WS_END = 1024 * MiB;
constexpr int CW_BAR = 1024;
constexpr int CW_PANEL = 10240, CW_CTXC = 10752;
constexpr int CW_PAIR = 8192;

constexpr int RING_OFF = 0, RING_BYTES = 131072;
constexpr int LDSCTL_OFF = RING_BYTES, MISC_OFF = LDSCTL_OFF + 320;
constexpr int XB_OFF = LDSCTL_OFF + 1024;
constexpr int LDS_BYTES = 147456;

struct Args { const float* in[N_IN]; float* out; unsigned char* ws; int ph_lo, ph_hi; };
struct Frame {
    LAS unsigned char* lds;
    int tid, lane, wave, gw, ngw;
};
constexpr int PTAB_OFF = LDS_BYTES - 512;
DI const float* inp(const Frame& F, int i) {
    const v2u w = *(const LAS v2u*)(F.lds + PTAB_OFF + 8 * i);
    const unsigned lo = __builtin_amdgcn_readfirstlane(w.x), hi = __builtin_amdgcn_readfirstlane(w.y);
    return (const float*)(const GAS float*)(((unsigned long long)hi << 32) | lo);
}
template <int CTRL> DI float dppf(float x) { return __builtin_bit_cast(float, __builtin_amdgcn_update_dpp(0, __builtin_bit_cast(int, x), CTRL, 0xf, 0xf, false)); }
DI float bperm(float x, int src_lane) { return __builtin_bit_cast(float, __builtin_amdgcn_ds_bpermute(src_lane << 2, __builtin_bit_cast(int, x))); }
DI float sum4(float v) { v += dppf<0xB1>(v); v += dppf<0x4E>(v); return v; }
DI float sum8(float v) { v = sum4(v); v += dppf<0x141>(v); return v; }
DI float sum16(float v) { v = sum8(v); v += dppf<0x140>(v); return v; }
DI float wave_sum(float v) {
    v = sum16(v);
    return (__builtin_amdgcn_readlane(v, 0) + __builtin_amdgcn_readlane(v, 16)) + (__builtin_amdgcn_readlane(v, 32) + __builtin_amdgcn_readlane(v, 48));
}
DI float silu_f(float x) { return x / (1.f + __expf(-x)); }
DI void unpack8(const bf16x8 v, float (&f)[8]) {
    const v4u w = __builtin_bit_cast(v4u, v);
    f[0] = bflo(w.x); f[1] = bfhi(w.x); f[2] = bflo(w.y); f[3] = bfhi(w.y); f[4] = bflo(w.z); f[5] = bfhi(w.z); f[6] = bflo(w.w); f[7] = bfhi(w.w);
}
DI v4u pack8(const float (&f)[8]) { v4u w; w.x = pk2(f[0], f[1]); w.y = pk2(f[2], f[3]); w.z = pk2(f[4], f[5]); w.w = pk2(f[6], f[7]); return w; }

DI void p0_transpose_item(const float* W, int K, int N, bf16* WT, LAS float* scr, int item, int lane, bool perm_up = false) {
    const int nblk = N / 32, kb = item / nblk, nb = item % nblk, k0 = 64 * kb, n0 = 32 * nb;
#pragma unroll 8
    for (int i = 0; i < 32; ++i) { const int kk = 2 * i + (lane >> 5); scr[kk * 33 + (lane & 31)] = W[(size_t)(k0 + kk) * N + n0 + (lane & 31)]; }
    LDS_WAIT(); asm volatile("" ::: "memory");
    const int c = lane & 7;
#pragma unroll
    for (int j = 0; j < 4; ++j) { const int n = (lane >> 3) + 8 * j; const LAS float* s = scr + (8 * c) * 33 + n;
        v4u o; o.x = pk2(s[0 * 33], s[1 * 33]); o.y = pk2(s[2 * 33], s[3 * 33]); o.z = pk2(s[4 * 33], s[5 * 33]); o.w = pk2(s[6 * 33], s[7 * 33]);
        const int nn = n0 + n; const int nrow = perm_up ? ((nn % FF) / 128) * 256 + (nn / FF) * 128 + (nn % 128) : nn;
        *(v4u*)(WT + (size_t)nrow * K + k0 + 8 * c) = o; }
    LDS_WAIT(); asm volatile("" ::: "memory");
}
#ifndef P0_ABL
#define P0_ABL 0
#endif
DI void p0_prologue(const Args& a, Frame& F, int rep = 0) {
    const bool skipT = rep > 0 && (P0_ABL & 1), skipM = rep > 0 && (P0_ABL & 2);
    unsigned char* ws = a.ws;
    LAS float* scr = (LAS float*)(F.lds + RING_OFF + F.wave * 16384);
    constexpr int IT_IN = (DM / 64) * (INC / 32), IT_OUT = (DM / 64) * (DM / 32), IT_UP = (DM / 64) * (FF2 / 32), IT_DN = (FF / 64) * (DM / 32), IT_QB = (512 / 64) * (768 / 32), IT_KVB = (256 / 64) * (1024 / 32);
    constexpr int IT_L = IT_IN + IT_OUT + IT_UP + IT_DN + IT_QB + IT_KVB;
    for (int it = F.gw; it < (skipT ? 0 : DEPTH * IT_L); it += F.ngw) {
        const int l = it / IT_L; int r = it % IT_L;
        if (r < IT_IN) { p0_transpose_item(inp(F, I_WIN) + (size_t)l * DM * INC, DM, INC, (bf16*)(ws + WS_WIN) + (size_t)l * INP * DM, scr, r, F.lane); continue; } r -= IT_IN;
        if (r < IT_OUT) { const int kb = r / (DM / 32);
            if (kb >= 8 && kb < 16) p0_transpose_item(inp(F, I_WOUT) + (size_t)l * DM * DM + (size_t)512 * DM, 512, DM, (bf16*)(ws + WS_WOP) + (size_t)l * DM * 512, scr, r - 8 * (DM / 32), F.lane);
            else p0_transpose_item(inp(F, I_WOUT) + (size_t)l * DM * DM, DM, DM, (bf16*)(ws + WS_WOUT) + (size_t)l * DM * DM, scr, r, F.lane);
            continue; } r -= IT_OUT;
        if (r < IT_UP) { p0_transpose_item(inp(F, I_WUP) + (size_t)l * DM * FF2, DM, FF2, (bf16*)(ws + WS_WUP) + (size_t)l * FF2 * DM, scr, r, F.lane, true); continue; } r -= IT_UP;
        if (r < IT_DN) { p0_transpose_item(inp(F, I_WDN) + (size_t)l * FF * DM, FF, DM, (bf16*)(ws + WS_WDN) + (size_t)l * DM * FF, scr, r, F.lane); continue; } r -= IT_DN;
        if (r < IT_QB) { p0_transpose_item(inp(F, I_WQB) + (size_t)l * 512 * 768, 512, 768, (bf16*)(ws + WS_WQB) + (size_t)l * 768 * 512, scr, r, F.lane); continue; } r -= IT_QB;
        p0_transpose_item(inp(F, I_WKVB) + (size_t)l * 256 * 1024, 256, 1024, (bf16*)(ws + WS_WKVB) + (size_t)l * 1024 * 256, scr, r, F.lane);
    }
    const int gt = F.gw * 64 + F.lane, ngt = F.ngw * 64;
    for (int i = gt; i < DEPTH * (INP - INC) * (DM / 8); i += ngt) { const int l = i / ((INP - INC) * (DM / 8)), r = i % ((INP - INC) * (DM / 8));
        *(v4u*)((bf16*)(ws + WS_WIN) + (size_t)l * INP * DM + (size_t)INC * DM + (size_t)r * 8) = (v4u){0u, 0u, 0u, 0u}; }
    for (int i = gt; i < DEPTH * 512 * 64; i += ngt) { const int l = i / (512 * 64), r = i % (512 * 64), k = r / 64, d0 = (r % 64) * 8; const int g = k >> 7, c = k & 127, g2 = d0 >> 7, dd = d0 & 127;
        v4u o = (v4u){0u, 0u, 0u, 0u};
        if (g == g2) { const float* s = inp(F, I_POOLW) + (((size_t)l * 4 + g) * 128 + c) * 128 + dd; const float* sc = inp(F, I_POOLS) + (size_t)l * 512 + g * 128 + dd;
            o.x = pk2(s[0] * sc[0], s[1] * sc[1]); o.y = pk2(s[2] * sc[2], s[3] * sc[3]); o.z = pk2(s[4] * sc[4], s[5] * sc[5]); o.w = pk2(s[6] * sc[6], s[7] * sc[7]); }
        *(v4u*)((bf16*)(ws + WS_WPOOL) + (size_t)l * 512 * 512 + (size_t)k * 512 + d0) = o; }
    for (int i = gt; i < 1024; i += ngt) { const int pos = i >> 4, fi = i & 15; const float inv = powf(10000.0f, -(float)(2 * fi) / 32.0f); const float ang = (float)pos * inv;
        ((f32x2*)(ws + WS_ROPE))[i] = (f32x2){cosf(ang), sinf(ang)}; }
    __syncthreads();
    LAS float* sl = (LAS float*)(F.lds + RING_OFF);
    LAS float* red = (LAS float*)(F.lds + RING_OFF + 24576);
    if (!skipM) for (int i = F.tid; i < 3 * DM; i += NTHREADS) { const int r = i / DM, k = i % DM; sl[i] = silu_f(r < 2 ? inp(F, I_C)[r * DM + k] : inp(F, I_CCTX)[k]); }
    __syncthreads();
    for (int u = blockIdx.x; u < (skipM ? 0 : DEPTH * 64); u += gridDim.x) {
        const int l = u >> 6, n0 = (u & 63) * 192;
        const float* W = inp(F, I_WMOD) + (size_t)l * DM * 12288 + n0 + F.lane * 3;
        float acc[3][3];
#pragma unroll
        for (int r = 0; r < 3; ++r)
#pragma unroll
            for (int j = 0; j < 3; ++j) acc[r][j] = 0.f;
        const int kb = F.wave * 256;
#pragma unroll 16
        for (int k = kb; k < kb + 256; ++k) { const float* wp = W + (size_t)k * 12288; const float w0 = wp[0], w1 = wp[1], w2 = wp[2];
            const float s0 = sl[k], s1 = sl[DM + k], s2 = sl[2 * DM + k];
            acc[0][0] += s0 * w0; acc[0][1] += s0 * w1; acc[0][2] += s0 * w2; acc[1][0] += s1 * w0; acc[1][1] += s1 * w1; acc[1][2] += s1 * w2; acc[2][0] += s2 * w0; acc[2][1] += s2 * w1; acc[2][2] += s2 * w2; }
#pragma unroll
        for (int r = 0; r < 3; ++r)
#pragma unroll
            for (int j = 0; j < 3; ++j) red[(F.wave * 9 + r * 3 + j) * 64 + F.lane] = acc[r][j];
        __syncthreads();
        for (int o = F.tid; o < 3 * 192; o += NTHREADS) { const int r = o / 192, c = o % 192, ln = c / 3, j = c % 3; float sum = inp(F, I_BMOD)[(size_t)l * 12288 + n0 + c];
#pragma unroll
            for (int w = 0; w < 8; ++w) sum += red[(w * 9 + r * 3 + j) * 64 + ln];
            ((float*)(ws + WS_MOD))[((size_t)l * 3 + r) * 12288 + n0 + c] = sum; }
        __syncthreads();
    }
}

DI void norm_phase(Frame& F, const float* xlat, const float* xctx, const float* g, const float* modl, int ch_shift, int ch_scale, bf16* H, int nrows,
                   const float* slab, int nsplit, const float* cgate, float* xctx_out, int mode = 0, int lat_base = 0) {
    int wrows = nrows;
    if (nsplit > 0 && mode != 1) {
        wrows = NLAT;
        LAS float* red = (LAS float*)(F.lds + RING_OFF);
        const float* sh = modl + (size_t)2 * 12288 + ch_shift * DM; const float* sc = modl + (size_t)2 * 12288 + ch_scale * DM;
        const int c = F.wave * 256 + 4 * F.lane;
        for (int cr = blockIdx.x; cr < NCTX; cr += gridDim.x) {
            f32x4 v = *(const f32x4*)(xctx + (size_t)cr * DM + c);
            const float* sp = slab + (size_t)cr * DM + c;
            f32x4 acc = *(const f32x4*)sp;
            for (int s2 = 1; s2 < nsplit; ++s2) acc += *(const f32x4*)(sp + (size_t)s2 * NCTX * DM);
            v += *(const f32x4*)(cgate + c) * acc;
            *(f32x4*)(xctx_out + (size_t)cr * DM + c) = v;
            const float ssw = wave_sum((v.x * v.x + v.y * v.y) + (v.z * v.z + v.w * v.w));
            if (F.lane == 0) red[F.wave] = ssw;
            __syncthreads();
            float ss = 0.f;
#pragma unroll
            for (int w = 0; w < 8; ++w) ss += red[w];
            const float rstd = 1.0f / sqrtf(ss * (1.0f / DM) + EPS);
            const f32x4 gg = *(const f32x4*)(g + c), s1 = *(const f32x4*)(sc + c), s0 = *(const f32x4*)(sh + c);
            const f32x4 y = (v * rstd * gg) * (s1 + 1.0f) + s0;
            v2u o; o.x = pk2(y.x, y.y); o.y = pk2(y.z, y.w); *(v2u*)(H + (size_t)(NLAT + cr) * DM + c) = o;
            __syncthreads();
        }
    }
    if (mode == 2) wrows = 0;
    for (int r4 = mode == 1 ? lat_base + F.wave * 4 : F.gw * 4; r4 < (mode == 1 ? lat_base + 32 : wrows); r4 += F.ngw * 4) {
        const int bid = r4 < SEQ ? 0 : (r4 < NLAT ? 1 : 2);
        const float* sh = modl + (size_t)bid * 12288 + ch_shift * DM; const float* sc = modl + (size_t)bid * 12288 + ch_scale * DM;
        f32x4 ga[8], sb[8];
#pragma unroll
        for (int j = 0; j < 8; ++j) { const int c = 256 * j + 4 * F.lane; ga[j] = *(const f32x4*)(g + c) * (*(const f32x4*)(sc + c) + 1.0f); sb[j] = *(const f32x4*)(sh + c); }
        const float* src0 = r4 < NLAT ? xlat + (size_t)r4 * DM : xctx + (size_t)(r4 - NLAT) * DM;
        f32x4 v[8], nx[8];
#pragma unroll
        for (int j = 0; j < 8; ++j) v[j] = *(const f32x4*)(src0 + 256 * j + 4 * F.lane);
#pragma unroll
        for (int rr = 0; rr < 4; ++rr) {
            if (rr < 3) {
#pragma unroll
                for (int j = 0; j < 8; ++j) nx[j] = *(const f32x4*)(src0 + (size_t)(rr + 1) * DM + 256 * j + 4 * F.lane); }
            float ss = 0.f;
#pragma unroll
            for (int j = 0; j < 8; ++j) ss += (v[j].x * v[j].x + v[j].y * v[j].y) + (v[j].z * v[j].z + v[j].w * v[j].w);
            const float rstd = 1.0f / sqrtf(wave_sum(ss) * (1.0f / DM) + EPS);
#pragma unroll
            for (int j = 0; j < 8; ++j) { const f32x4 y = (v[j] * rstd) * ga[j] + sb[j];
                v2u o; o.x = pk2(y.x, y.y); o.y = pk2(y.z, y.w); *(v2u*)(H + (size_t)(r4 + rr) * DM + 256 * j + 4 * F.lane) = o; }
#pragma unroll
            for (int j = 0; j < 8; ++j) v[j] = nx[j];
        }
    }
}

DI void count_publish(const Frame& F, unsigned* cnt) {
    if (F.wave == 0 && fresh_lane() == 0) { __builtin_amdgcn_fence(__ATOMIC_RELEASE, "agent"); VM_WAIT(); (void)__hip_atomic_fetch_add(cnt, 1u, __ATOMIC_RELAXED, __HIP_MEMORY_SCOPE_AGENT); }
}
DI void count_wait(const Frame& F, unsigned* cnt, unsigned want) {
    if (F.wave == 0) { unsigned sp = 0u;
        while ((unsigned)__builtin_amdgcn_readfirstlane(__hip_atomic_load(cnt, __ATOMIC_RELAXED, __HIP_MEMORY_SCOPE_AGENT)) < want) { __builtin_amdgcn_s_sleep(2); if (++sp > (1u << 20)) break; }
        __builtin_amdgcn_fence(__ATOMIC_ACQUIRE, "agent"); }
    VM_WAIT(); __syncthreads();
}


DI int pi32(int r) { return (r & ~12) | ((r & 4) << 1) | ((r & 8) >> 1); }
DI size_t kimg_off(int kidx, int c) { return (size_t)(kidx >> 5) * 12288 + (size_t)(c >> 1) * 1024 + (size_t)(((c & 1) * 32 + pi32(kidx & 31)) * 16); }
DI size_t vimg_off(int kidx0, int d) { return (size_t)(kidx0 >> 5) * 8192 + (size_t)((((((kidx0 >> 4) & 1) * 4 + (d >> 5)) * 64) + ((kidx0 >> 3) & 1) * 32 + (d & 31)) * 16); }
constexpr size_t KIMG_BH = (size_t)(NKEY / 32) * 12288, VIMG_BH = (size_t)(NKEY / 32) * 8192;
struct RowInfo { int lat, b, t, kidx, prow, pcol; };
DI RowInfo row_info(int r) { RowInfo q; q.lat = r < NLAT; q.b = q.lat ? (r >> 12) : ((r - NLAT) >> 8); q.t = q.lat ? (r & (SEQ - 1)) : ((r - NLAT) & (CTXL - 1)); q.kidx = q.lat ? q.t : SEQ + q.t; q.prow = q.t >> 6; q.pcol = q.t & 63; return q; }
DI void rope8(float (&y)[8], int d0, const RowInfo& ri, const f32x2* rope) {
    const int seg = d0 >> 5, second = (d0 >> 4) & 1, i0 = d0 & 15; const int pos = seg ? ri.pcol : ri.prow;
#pragma unroll
    for (int j = 0; j < 8; ++j) { const float yp = dppf<0x4E>(y[j]); const f32x2 cs = rope[pos * 16 + i0 + j];
        y[j] = second ? (y[j] * cs.x + yp * cs.y) : (y[j] * cs.x - yp * cs.y); }
}
#ifndef PREP_ABL
#define PREP_ABL 0
#endif
DI void prep_phase(const Args& a, Frame& F, int l, int rep = 0) {
    const bool skipA = rep > 0 && (PREP_ABL & 1), skipB = rep > 0 && (PREP_ABL & 2);
    unsigned char* ws = a.ws;
    const bf16* P = (const bf16*)(ws + WS_P);
    const f32x2* rope = (const f32x2*)(ws + WS_ROPE);
    const float* g_qa = inp(F, I_QAN) + l * 512, *g_kva = inp(F, I_KVAN) + l * 256, *g_kr = inp(F, I_KRN) + l * 64;
    const float* g_sq = inp(F, I_SQN) + l * 64, *g_sk = inp(F, I_SKN) + l * 64, *g_nq = inp(F, I_NQN) + l * 64, *g_nk = inp(F, I_NKN) + l * 64;
    const int lane = F.lane;
    float gq_qa[8], gq_sq[8], gq_sk[8], gq_nq[8], gq_nk[8];
    { const int d0h = (lane & 7) * 8;
#pragma unroll
      for (int j = 0; j < 8; ++j) { gq_qa[j] = g_qa[lane * 8 + j]; gq_sq[j] = g_sq[d0h + j]; gq_sk[j] = g_sk[d0h + j]; gq_nq[j] = g_nq[d0h + j]; gq_nk[j] = g_nk[d0h + j]; } }
    const f32x4 gq_kva = *(const f32x4*)(g_kva + lane * 4); const float gq_kr = g_kr[lane];
    for (int r = F.gw; r < (skipA ? 0 : NROW); r += F.ngw) {
        const RowInfo ri = row_info(r); const bf16* prow = P + (size_t)r * INP;
        const int l16 = lane & 15, d0 = (lane & 7) * 8;
        const bf16x8 v_cq = *(const bf16x8*)(prow + C_CQ + lane * 8);
        const v2u v_ckv = *(const v2u*)(prow + C_CKV + lane * 4);
        const float x_kr = bf2f(prow[C_KR + lane]);
        const bf16x8 v_pool = *(const bf16x8*)(prow + C_POOL + lane * 8);
        const bf16x8 v_sq = *(const bf16x8*)(prow + C_SQ + lane * 8);
        const bf16x8 v_sk = *(const bf16x8*)(prow + C_SK + l16 * 8);
        const bf16x8 v_nq = *(const bf16x8*)(prow + C_NQ + lane * 8);
        const bf16x8 v_nk = *(const bf16x8*)(prow + C_NK + lane * 8);
        { const int g = lane >> 4, hw = 1 << g, n = ri.lat ? SEQ : CTXL; const int lo = max(ri.t - hw, 0), hi = min(ri.t + hw, n);
          float s[8];
#pragma unroll
          for (int j = 0; j < 8; ++j) s[j] = 0.f;
          const bf16* pb = P + (size_t)(r - ri.t) * INP + C_POOL + lane * 8;
          bf16x8 wv[16];
#pragma unroll
          for (int q = 0; q < 16; ++q) wv[q] = *(const bf16x8*)(pb + (size_t)min(lo + q, hi - 1) * INP);
#pragma unroll
          for (int q = 0; q < 16; ++q) { float f[8]; unpack8(wv[q], f); const float msk = (lo + q < hi) ? 1.0f : 0.0f;
#pragma unroll
              for (int j = 0; j < 8; ++j) s[j] += msk * f[j]; }
          float f[8]; unpack8(v_pool, f); const float inv = 1.0f / (float)(hi - lo);
#pragma unroll
          for (int j = 0; j < 8; ++j) s[j] = s[j] * inv - f[j];
          *(v4u*)((bf16*)(ws + WS_MIX) + (size_t)r * DM + 512 + lane * 8) = pack8(s); }
        { float f[8]; unpack8(v_cq, f); float ss = 0.f;
#pragma unroll
          for (int j = 0; j < 8; ++j) ss += f[j] * f[j];
          const float rstd = 1.0f / sqrtf(wave_sum(ss) * (1.0f / 512) + EPS);
#pragma unroll
          for (int j = 0; j < 8; ++j) f[j] = f[j] * rstd * gq_qa[j];
          *(v4u*)((bf16*)(ws + WS_QN) + (size_t)r * 512 + lane * 8) = pack8(f); }
        { const v2u w = v_ckv; float f0 = bflo(w.x), f1 = bfhi(w.x), f2 = bflo(w.y), f3 = bfhi(w.y);
          const float rstd = 1.0f / sqrtf(wave_sum(f0 * f0 + f1 * f1 + f2 * f2 + f3 * f3) * (1.0f / 256) + EPS);
          const f32x4 gg = gq_kva;
          v2u o; o.x = pk2(f0 * rstd * gg.x, f1 * rstd * gg.y); o.y = pk2(f2 * rstd * gg.z, f3 * rstd * gg.w);
          *(v2u*)((bf16*)(ws + WS_KVN) + (size_t)r * 256 + lane * 4) = o; }
        { const float x = x_kr; const float rstd = 1.0f / sqrtf(wave_sum(x * x) * (1.0f / 64) + EPS);
          float y = x * rstd * gq_kr;
          const float yp = bperm(y, lane ^ 16);
          if (ri.lat) { const int pos = (lane & 32) ? ri.pcol : ri.prow; const f32x2 cs = rope[pos * 16 + (lane & 15)];
              y = (lane & 16) ? (y * cs.x + yp * cs.y) : (y * cs.x - yp * cs.y); }
          float e[8];
#pragma unroll
          for (int j = 0; j < 8; ++j) e[j] = bperm(y, (lane & ~7) + j);
          if ((lane & 7) == 0) { const v4u o = pack8(e);
#pragma unroll
              for (int h = 0; h < 4; ++h) *(v4u*)(ws + WS_KMLA + (size_t)(ri.b * 4 + h) * KIMG_BH + kimg_off(ri.kidx, 16 + (lane >> 3))) = o; } }
        { float f[8]; unpack8(v_sq, f); float ss = 0.f;
#pragma unroll
          for (int j = 0; j < 8; ++j) ss += f[j] * f[j];
          ss = sum8(ss);
          const float rstd = 1.0f / sqrtf(ss * (1.0f / 64) + EPS);
#pragma unroll
          for (int j = 0; j < 8; ++j) f[j] = f[j] * rstd * gq_sq[j];
          if (ri.lat) rope8(f, d0, ri, rope);
          *(v4u*)((bf16*)(ws + WS_QSWA) + ((size_t)(ri.b * 8 + (lane >> 3)) * NKEY + ri.kidx) * 64 + d0) = pack8(f); }
        { float f[8]; unpack8(v_sk, f); float ss = 0.f;
#pragma unroll
          for (int j = 0; j < 8; ++j) ss += f[j] * f[j];
          ss = sum8(ss);
          const float rstd = 1.0f / sqrtf(ss * (1.0f / 64) + EPS);
#pragma unroll
          for (int j = 0; j < 8; ++j) f[j] = f[j] * rstd * gq_sk[j];
          if (ri.lat) rope8(f, d0, ri, rope);
          if (lane < 16) *(v4u*)((bf16*)(ws + WS_KSWA) + ((size_t)(ri.b * 2 + (lane >> 3)) * NKEY + ri.kidx) * 64 + d0) = pack8(f); }
        { float f[8]; unpack8(v_nq, f); float ss = 0.f;
#pragma unroll
          for (int j = 0; j < 8; ++j) ss += f[j] * f[j];
          ss = sum8(ss);
          const float rstd = 1.0f / sqrtf(ss * (1.0f / 64) + EPS);
#pragma unroll
          for (int j = 0; j < 8; ++j) f[j] = f[j] * rstd * gq_nq[j];
          *(v4u*)((bf16*)(ws + WS_QNA) + ((size_t)(ri.b * 8 + (lane >> 3)) * NKEY + ri.kidx) * 64 + d0) = pack8(f); }
        { float f[8]; unpack8(v_nk, f); float ss = 0.f;
#pragma unroll
          for (int j = 0; j < 8; ++j) ss += f[j] * f[j];
          ss = sum8(ss);
          const float rstd = 1.0f / sqrtf(ss * (1.0f / 64) + EPS);
#pragma unroll
          for (int j = 0; j < 8; ++j) f[j] = f[j] * rstd * gq_nk[j];
          *(v4u*)((bf16*)(ws + WS_KNA) + ((size_t)(ri.b * 8 + (lane >> 3)) * NKEY + ri.kidx) * 64 + d0) = pack8(f); }
    }
    for (int it = F.gw; it < (skipB ? 0 : (NROW / 8) * 5); it += F.ngw) {
        const int grp = it / 5, ch = it % 5; const int r0 = grp * 8; const RowInfo ri = row_info(r0);
        const bf16* src = P + (size_t)r0 * INP + (ch == 0 ? C_SV : C_NV + (ch - 1) * 128) + 2 * lane;
        unsigned e[8];
#pragma unroll
        for (int k = 0; k < 8; ++k) e[k] = *(const unsigned*)(src + (size_t)k * INP);
        v4u lo, hi;
        lo.x = (e[0] & 0xffffu) | (e[1] << 16); lo.y = (e[2] & 0xffffu) | (e[3] << 16); lo.z = (e[4] & 0xffffu) | (e[5] << 16); lo.w = (e[6] & 0xffffu) | (e[7] << 16);
        hi.x = (e[0] >> 16) | (e[1] & 0xffff0000u); hi.y = (e[2] >> 16) | (e[3] & 0xffff0000u); hi.z = (e[4] >> 16) | (e[5] & 0xffff0000u); hi.w = (e[6] >> 16) | (e[7] & 0xffff0000u);
        const int dd = 2 * lane, hsel = dd >> 6, d = dd & 63;
        bf16* dst = ch == 0 ? (bf16*)(ws + WS_VTSWA) + ((size_t)(ri.b * 2 + hsel) * 64 + d) * NKEY + ri.kidx : (bf16*)(ws + WS_VTNA) + ((size_t)(ri.b * 8 + (ch - 1) * 2 + hsel) * 64 + d) * NKEY + ri.kidx;
        *(v4u*)dst = lo; *(v4u*)(dst + NKEY) = hi;
    }
}

DI void post_phase(const Args& a, Frame& F, int l) {
    unsigned char* ws = a.ws;
    const bf16* QR = (const bf16*)(ws + WS_QRAW); const bf16* KVR = (const bf16*)(ws + WS_KVRAW);
    const f32x2* rope = (const f32x2*)(ws + WS_ROPE);
    const float* g_qn = inp(F, I_QNN) + l * 128, *g_qr = inp(F, I_QRN) + l * 64, *g_kn = inp(F, I_KNN) + l * 128;
    const int lane = F.lane;
    float gq_q[8], gq_k[8];
    { const int li0 = lane & 31; const float* gp0 = li0 >= 16 ? g_qr + ((li0 - 16) & 7) * 8 : g_qn + (li0 & 15) * 8;
#pragma unroll
      for (int j = 0; j < 8; ++j) { gq_q[j] = gp0[j]; gq_k[j] = g_kn[(lane & 15) * 8 + j]; } }
    for (int r = F.gw; r < NROW; r += F.ngw) {
        const RowInfo ri = row_info(r);
        const int li = lane & 31; const bool active = li < 24, isrope = li >= 16;
        const int coff = isrope ? 128 + (li - 16) * 8 : li * 8;
        bf16x8 vq[2];
#pragma unroll
        for (int pp = 0; pp < 2; ++pp) vq[pp] = *(const bf16x8*)(QR + (size_t)r * 768 + (2 * pp + (lane >> 5)) * 192 + (active ? coff : 0));
        const int khead = lane >> 4, ch = lane & 15;
        const bf16x8 vk = *(const bf16x8*)(KVR + (size_t)r * 1024 + khead * 256 + ch * 8);
#pragma unroll
        for (int pp = 0; pp < 2; ++pp) {
            const int head = 2 * pp + (lane >> 5);
            float f[8]; unpack8(vq[pp], f);
            if (!active) {
#pragma unroll
                for (int j = 0; j < 8; ++j) f[j] = 0.f; }
            float ss = 0.f;
#pragma unroll
            for (int j = 0; j < 8; ++j) ss += f[j] * f[j];
            ss = sum8(ss); const float s16 = ss + dppf<0x140>(ss);
            const float rstd = isrope ? 1.0f / sqrtf(ss * (1.0f / 64) + EPS) : 1.0f / sqrtf(s16 * (1.0f / 128) + EPS);
#pragma unroll
            for (int j = 0; j < 8; ++j) f[j] = f[j] * rstd * gq_q[j];
            if (ri.lat) { float y[8];
#pragma unroll
                for (int j = 0; j < 8; ++j) y[j] = f[j];
                rope8(y, ((li - 16) & 7) * 8, ri, rope);
                if (isrope) {
#pragma unroll
                    for (int j = 0; j < 8; ++j) f[j] = y[j]; } }
            if (active) *(v4u*)((bf16*)(ws + WS_QMLA) + ((size_t)(ri.b * 4 + head) * NKEY + ri.kidx) * 192 + coff) = pack8(f);
        }
        { float f[8]; unpack8(vk, f); float ss = 0.f;
#pragma unroll
          for (int j = 0; j < 8; ++j) ss += f[j] * f[j];
          ss = sum16(ss);
          const float rstd = 1.0f / sqrtf(ss * (1.0f / 128) + EPS);
#pragma unroll
          for (int j = 0; j < 8; ++j) f[j] = f[j] * rstd * gq_k[j];
          *(v4u*)(ws + WS_KMLA + (size_t)(ri.b * 4 + khead) * KIMG_BH + kimg_off(ri.kidx, ch)) = pack8(f); }
    }
    for (int it = F.gw; it < (NROW / 8) * 4; it += F.ngw) {
        const int grp = it >> 2, head = it & 3; const int r0 = grp * 8; const RowInfo ri = row_info(r0); const int d = 2 * lane;
        const bf16* src = KVR + (size_t)r0 * 1024 + head * 256 + 128 + d;
        unsigned e[8];
#pragma unroll
        for (int k = 0; k < 8; ++k) e[k] = *(const unsigned*)(src + (size_t)k * 1024);
        v4u lo, hi;
        lo.x = (e[0] & 0xffffu) | (e[1] << 16); lo.y = (e[2] & 0xffffu) | (e[3] << 16); lo.z = (e[4] & 0xffffu) | (e[5] << 16); lo.w = (e[6] & 0xffffu) | (e[7] << 16);
        hi.x = (e[0] >> 16) | (e[1] & 0xffff0000u); hi.y = (e[2] >> 16) | (e[3] & 0xffff0000u); hi.z = (e[4] >> 16) | (e[5] & 0xffff0000u); hi.w = (e[6] >> 16) | (e[7] & 0xffff0000u);
        unsigned char* vb = ws + WS_VTMLA + (size_t)(ri.b * 4 + head) * VIMG_BH;
        *(v4u*)(vb + vimg_off(ri.kidx, d)) = lo; *(v4u*)(vb + vimg_off(ri.kidx, d + 1)) = hi;
    }
}

#define MFMA32(a, b, c) __builtin_amdgcn_mfma_f32_32x32x16_bf16((a), (b), (c), 0, 0, 0)
typedef __bf16 bf16x2_t __attribute__((ext_vector_type(2)));
DI unsigned cvtpk_s(float lo, float hi) { f32x2 v = {lo, hi}; bf16x2_t b = __builtin_convertvector(v, bf16x2_t); return __builtin_bit_cast(unsigned, b); }
DI int keyof(int i, int h) { return 16 * (i >> 3) + 8 * h + (i & 7); }
DI float xhalf_max(float x) { const unsigned u = __builtin_bit_cast(unsigned, x); auto rr = __builtin_amdgcn_permlane32_swap(u, u, false, false);
    return fmaxf(__builtin_bit_cast(float, (unsigned)rr[0]), __builtin_bit_cast(float, (unsigned)rr[1])); }
DI float xhalf_sum(float x) { const unsigned u = __builtin_bit_cast(unsigned, x); auto rr = __builtin_amdgcn_permlane32_swap(u, u, false, false);
    return __builtin_bit_cast(float, (unsigned)rr[0]) + __builtin_bit_cast(float, (unsigned)rr[1]); }
constexpr float ATT_THR = 8.0f;

template <int DV>
DI void attn_softmax_pv(f32x16& s, const bf16x8 (&vf)[2][DV / 32], float& m, float& l, f32x16 (&o)[DV / 32], const float C = 1.0f) {
    float tmax = fmaxf(s[0], s[1]);
#pragma unroll
    for (int i = 2; i < 16; i += 2) tmax = fmaxf(fmaxf(tmax, s[i]), s[i + 1]);
    tmax = xhalf_max(tmax) * C;
    if (!__all(tmax <= m + ATT_THR)) {
        const float mn = fmaxf(m, tmax); const float alpha = __builtin_amdgcn_exp2f(m - mn); m = mn; l *= alpha;
#pragma unroll
        for (int db = 0; db < DV / 32; ++db)
#pragma unroll
            for (int i = 0; i < 16; ++i) o[db][i] *= alpha;
    }
    float ps = 0.f;
#pragma unroll
    for (int i = 0; i < 16; ++i) { s[i] = __builtin_amdgcn_exp2f(fmaf(s[i], C, -m)); ps += s[i]; }
    ps = xhalf_sum(ps);
    l += ps;
#pragma unroll
    for (int st = 0; st < 2; ++st) {
        v4u pw; pw.x = cvtpk_s(s[8 * st + 0], s[8 * st + 1]); pw.y = cvtpk_s(s[8 * st + 2], s[8 * st + 3]); pw.z = cvtpk_s(s[8 * st + 4], s[8 * st + 5]); pw.w = cvtpk_s(s[8 * st + 6], s[8 * st + 7]);
        const bf16x8 pf = __builtin_bit_cast(bf16x8, pw);
#pragma unroll
        for (int db = 0; db < DV / 32; ++db) o[db] = MFMA32(vf[st][db], pf, o[db]);
    }
}
DI void mla_softmax_pv(f32x16& s, const LAS unsigned char* vt, float& m, float& l, f32x16 (&o)[4], const float C) {
    bf16x8 va[4];
#pragma unroll
    for (int db = 0; db < 4; ++db) va[db] = *(const LAS bf16x8*)(vt + db * 1024);
    float tmax = fmaxf(s[0], s[1]);
#pragma unroll
    for (int i = 2; i < 16; i += 2) tmax = fmaxf(fmaxf(tmax, s[i]), s[i + 1]);
    tmax = xhalf_max(tmax) * C;
    if (!__all(tmax <= m + ATT_THR)) {
        const float mn = fmaxf(m, tmax); const float alpha = __builtin_amdgcn_exp2f(m - mn); m = mn; l *= alpha;
#pragma unroll
        for (int db = 0; db < 4; ++db)
#pragma unroll
            for (int i = 0; i < 16; ++i) o[db][i] *= alpha;
    }
    float ps = 0.f;
#pragma unroll
    for (int i = 0; i < 16; ++i) { s[i] = __builtin_amdgcn_exp2f(fmaf(s[i], C, -m)); ps += s[i]; }
    ps = xhalf_sum(ps);
    l += ps;
    { v4u pw; pw.x = cvtpk_s(s[0], s[1]); pw.y = cvtpk_s(s[2], s[3]); pw.z = cvtpk_s(s[4], s[5]); pw.w = cvtpk_s(s[6], s[7]);
      const bf16x8 pf = __builtin_bit_cast(bf16x8, pw);
#pragma unroll
      for (int db = 0; db < 4; ++db) o[db] = MFMA32(va[db], pf, o[db]); }
    asm volatile("" ::: "memory");
#pragma unroll
    for (int db = 0; db < 4; ++db) va[db] = *(const LAS bf16x8*)(vt + (4 + db) * 1024);
    { v4u pw; pw.x = cvtpk_s(s[8], s[9]); pw.y = cvtpk_s(s[10], s[11]); pw.z = cvtpk_s(s[12], s[13]); pw.w = cvtpk_s(s[14], s[15]);
      const bf16x8 pf = __builtin_bit_cast(bf16x8, pw);
#pragma unroll
      for (int db = 0; db < 4; ++db) o[db] = MFMA32(va[db], pf, o[db]); }
}
template <int DV>
DI void attn_store(const f32x16 (&o)[DV / 32], float l, bf16* orow, int h) {
    const float inv = 1.0f / l;
#pragma unroll
    for (int db = 0; db < DV / 32; ++db)
#pragma unroll
        for (int g = 0; g < 4; ++g) { v2u w; w.x = pk2(o[db][4 * g] * inv, o[db][4 * g + 1] * inv); w.y = pk2(o[db][4 * g + 2] * inv, o[db][4 * g + 3] * inv);
            *(v2u*)(orow + 32 * db + 8 * g + 4 * h) = w; }
}
template <int DQK> DI void load_q(bf16x8 (&qf)[DQK / 16], const bf16* qrow, int h) {
#pragma unroll
    for (int kk = 0; kk < DQK / 16; ++kk) qf[kk] = *(const bf16x8*)(qrow + 16 * kk + 8 * h);
}
template <int DV> DI void zero_o(f32x16 (&o)[DV / 32]) {
#pragma unroll
    for (int db = 0; db < DV / 32; ++db)
#pragma unroll
        for (int i = 0; i < 16; ++i) o[db][i] = 0.f;
}

struct Tile64 { bf16x8 kf[4]; bf16x8 vf[2][2]; };
DI void load_tile64(Tile64& T, const bf16* kb, const bf16* vb, int key0) {
#pragma unroll
    for (int kk = 0; kk < 4; ++kk) T.kf[kk] = *(const bf16x8*)(kb + (size_t)key0 * 64 + 16 * kk);
#pragma unroll
    for (int st = 0; st < 2; ++st)
#pragma unroll
        for (int db = 0; db < 2; ++db) T.vf[st][db] = *(const bf16x8*)(vb + (size_t)(32 * db) * NKEY + key0 + 16 * st);
}
struct Adj64 { int mode; int p0, p1, p2; const LAS float* rpb; };
DI void adjust64(f32x16& s, const Adj64& A, int key0, int h, int ql) {
    const int qp = A.p0 + ql;
#pragma unroll
    for (int i = 0; i < 16; ++i) { const int d = key0 + keyof(i, h) - qp; if (d > 128 || d < -128) s[i] = -__builtin_inff(); }
}
DI void adjust64_na(f32x16& s, const Adj64& A, int key0, int h, int ql, float C) {
    const int rq = A.p0 + (ql >> 4), cq = A.p1 * 16 + (ql & 15), kr = key0 >> 6, coloff = key0 & 63; const int r0 = min(max(rq - 4, 0), 56), c0 = min(max(cq - 8, 0), 48);
    const int rowb = ((kr >= r0 && kr < r0 + 8) ? (kr - rq + 7) : 15) * 128;
    const LAS unsigned char* tb = (const LAS unsigned char*)A.rpb + rowb;
    int bcol = coloff + 8 * h - cq + 15, bval = coloff + 8 * h - c0;
    asm volatile("" : "+v"(bcol), "+v"(bval));
#pragma unroll
    for (int i = 0; i < 16; ++i) { if (i == 8) asm volatile("" ::: "memory"); const int ci = 16 * (i >> 3) + (i & 7); const int off = ((unsigned)(bval + ci) < 16u) ? (bcol + ci) * 4 : 124;
        s[i] = fmaf(s[i], C, *(const LAS float*)(tb + off)); }
}
struct U64 {
    const bf16* qrow; const bf16* Kb; const bf16* Vb;
    int nloc, lstart;
    int mode, p0, p1, lo, hi, coloff;
    const float* rpb; float m0, l0; bf16* orow;
};
DI void tile64_lds(const LAS unsigned char* st, int off, const bf16x8 (&qf)[4], const Adj64& A, bool adj, int key0, float& m, float& lsum, f32x16 (&o)[2], int h, int ql, int pq) {
    int pq_ = pq, ql_ = ql; asm volatile("" : "+v"(pq_), "+v"(ql_));
    const int key = off + pq_; const int ka = key * 128, ksw = (key >> 1) & 7, vsw = (ql_ >> 1) & 7, kc0 = (off >> 3) + h;
    f32x16 s;
#pragma unroll
    for (int i = 0; i < 16; ++i) s[i] = 0.f;
#pragma unroll
    for (int kk = 0; kk < 4; ++kk) { const bf16x8 kf = *(const LAS bf16x8*)(st + ka + (((2 * kk + h) ^ ksw) << 4)); s = MFMA32(kf, qf[kk], s); }
    bf16x8 vf[2][2];
#pragma unroll
    for (int t = 0; t < 2; ++t)
#pragma unroll
        for (int db = 0; db < 2; ++db) vf[t][db] = *(const LAS bf16x8*)(st + 8192 + (32 * db + ql_) * 128 + (((kc0 + 2 * t) ^ vsw) << 4));
    const float C = 0.125f * LOG2E;
    if (adj) {
        if (A.mode == 2) adjust64_na(s, A, key0, h, ql, C);
        else {
#pragma unroll
            for (int i = 0; i < 16; ++i) s[i] *= C;
            adjust64(s, A, key0, h, ql); }
        attn_softmax_pv<64>(s, vf, m, lsum, o);
    } else attn_softmax_pv<64>(s, vf, m, lsum, o, C);
}
DI void run_wg64(Frame& F, const U64& U, int h, int ql) {
    const int lane = F.lane, pq = pi32(ql);
    bf16x8 qf[4]; load_q<64>(qf, U.qrow, h);
    f32x16 o[2]; zero_o<64>(o); float m = U.m0, lsum = U.l0;
    const LAS float* rtab = (const LAS float*)(F.lds + RING_OFF + 49152);
    const Adj64 A{U.mode, U.p0, U.p1, 0, rtab};
    const int nsteps = 4 + U.nloc;
    size_t goff[2]; const bf16* gb[2];
#pragma unroll
    for (int jj = 0; jj < 2; ++jj) { const int pp = F.wave * 2 + jj; const int row = 8 * (pp & 7) + (lane >> 3); const int ch = (lane & 7) ^ ((row >> 1) & 7);
        if (pp < 8) { gb[jj] = U.Kb; goff[jj] = (size_t)row * 64 + ch * 8; } else { gb[jj] = U.Vb; goff[jj] = (size_t)row * NKEY + ch * 8; } }
    const bool kp0 = (F.wave * 2) < 8;
#define U64_ISSUE(step) do { const int s_ = (step); const int bk_ = s_ < 4 ? SEQ + 64 * s_ : U.lstart + 64 * (s_ - 4); const size_t ko_ = kp0 ? (size_t)bk_ * 64 : (size_t)bk_; \
        _Pragma("unroll") for (int jj = 0; jj < 2; ++jj) __builtin_amdgcn_global_load_lds((const unsigned*)(gb[jj] + goff[jj] + ko_), (LAS unsigned*)(F.lds + RING_OFF + (s_ % 3) * 16384 + (F.wave * 2 + jj) * 1024), 16, 0, 0); } while (0)
    __syncthreads();
    if (U.mode == 2) { const int r = F.tid >> 5, c = F.tid & 31; ((LAS float*)(F.lds + RING_OFF + 49152))[F.tid] = (r < 15 && c < 31) ? U.rpb[r * 31 + c] * LOG2E : -__builtin_inff(); }
    U64_ISSUE(0); if (nsteps > 1) U64_ISSUE(1);
    for (int i = 0; i < nsteps; ++i) {
        if (i + 1 < nsteps) asm volatile("s_waitcnt vmcnt(2) lgkmcnt(0)\n\ts_barrier" ::: "memory"); else asm volatile("s_waitcnt vmcnt(0) lgkmcnt(0)\n\ts_barrier" ::: "memory");
        if (i + 2 < nsteps) U64_ISSUE(i + 2);
        const LAS unsigned char* st = F.lds + RING_OFF + (i % 3) * 16384;
        const int bk = i < 4 ? SEQ + 64 * i : U.lstart + 64 * (i - 4);
        if (i < 4) { tile64_lds(st, 0, qf, A, false, bk, m, lsum, o, h, ql, pq); tile64_lds(st, 32, qf, A, false, bk + 32, m, lsum, o, h, ql, pq); }
        else if (U.mode == 1) {
            if (bk >= U.lo && bk <= U.hi) tile64_lds(st, 0, qf, A, !(bk >= U.p0 - 97 && bk <= U.p0 + 97), bk, m, lsum, o, h, ql, pq);
            if (bk + 32 >= U.lo && bk + 32 <= U.hi) tile64_lds(st, 32, qf, A, !(bk + 32 >= U.p0 - 97 && bk + 32 <= U.p0 + 97), bk + 32, m, lsum, o, h, ql, pq);
        } else { const int kr = bk >> 6; if (kr >= U.lo && kr <= U.hi) tile64_lds(st, U.coloff, qf, A, true, bk + U.coloff, m, lsum, o, h, ql, pq); }
    }
#undef U64_ISSUE
    attn_store<64>(o, lsum, U.orow, h);
}

#ifndef PH_DUP
#define PH_DUP 0
#endif
#define ATT_REP1 (1 + (((PH_DUP) >> 12) & 1))
#define ATT_REP2 (1 + (((PH_DUP) >> 13) & 1))
DI void attn_phase(const Args& a, Frame& F, int l, bool do_ctx) {
    unsigned char* ws = a.ws;
    const bf16* QM = (const bf16*)(ws + WS_QMLA); const unsigned char* KI = ws + WS_KMLA; const unsigned char* VI = ws + WS_VTMLA;
    const bf16* QS = (const bf16*)(ws + WS_QSWA); const bf16* KS = (const bf16*)(ws + WS_KSWA); const bf16* VS = (const bf16*)(ws + WS_VTSWA);
    const bf16* QN_ = (const bf16*)(ws + WS_QNA); const bf16* KN_ = (const bf16*)(ws + WS_KNA); const bf16* VN_ = (const bf16*)(ws + WS_VTNA);
    bf16* MIX = (bf16*)(ws + WS_MIX);
    const int lane = F.lane, ql = lane & 31, h = lane >> 5;
    const float C_MLA = 0.07216878364870322f * LOG2E;
    constexpr int STAGE = 40960, TILEB = 20480, NSTEP = NKEY / 64, HSTEP = NSTEP / 2;
    unsigned* pflag = (unsigned*)(ws + WS_CTL) + CW_PAIR; float* ppart = (float*)(ws + WS_AUP);
    for (int rep1 = 0; rep1 < ATT_REP1; ++rep1)
    for (int u = blockIdx.x; u < 256; u += gridDim.x) {
        const int pair = u & 127, kz = 1 - (u >> 7); const int b = (pair >> 2) & 1, hd = pair & 3, qb = pair >> 3;
        const int bh = b * 4 + hd; const int tq = qb * 256 + F.wave * 32 + ql;
        bf16x8 qf[12]; load_q<192>(qf, QM + ((size_t)bh * NKEY + tq) * 192, h);
        f32x16 o[4]; zero_o<128>(o); float m = -1e30f, lsum = 0.f;
        const unsigned char* kimg = KI + (size_t)bh * KIMG_BH + (size_t)(kz * HSTEP) * 24576 + lane * 16; const unsigned char* vimg = VI + (size_t)bh * VIMG_BH + (size_t)(kz * HSTEP) * 16384 + lane * 16;
        __syncthreads();
        const int kp1 = F.wave + 8, kp2 = F.wave + 16;
        const int kd0 = F.wave * 1024, kd1 = (kp1 / 12) * TILEB + (kp1 % 12) * 1024, kd2 = (kp2 / 12) * TILEB + (kp2 % 12) * 1024, vd0 = 12288 + F.wave * 1024;
#define MLA_ISSUE(step, stage) do { const unsigned char* ks_ = kimg + (size_t)(step) * 24576 + F.wave * 1024; const unsigned char* vs_ = vimg + (size_t)(step) * 16384 + F.wave * 1024; \
            LAS unsigned char* sb_ = F.lds + RING_OFF + (stage) * STAGE; \
            __builtin_amdgcn_global_load_lds((const unsigned*)ks_, (LAS unsigned*)(sb_ + kd0), 16, 0, 0); \
            __builtin_amdgcn_global_load_lds((const unsigned*)(ks_ + 8192), (LAS unsigned*)(sb_ + kd1), 16, 0, 0); \
            __builtin_amdgcn_global_load_lds((const unsigned*)(ks_ + 16384), (LAS unsigned*)(sb_ + kd2), 16, 0, 0); \
            __builtin_amdgcn_global_load_lds((const unsigned*)vs_, (LAS unsigned*)(sb_ + vd0), 16, 0, 0); \
            __builtin_amdgcn_global_load_lds((const unsigned*)(vs_ + 8192), (LAS unsigned*)(sb_ + TILEB + vd0), 16, 0, 0); } while (0)
        MLA_ISSUE(0, 0);
        for (int i = 0; i < HSTEP; ++i) {
            VM_WAIT(); __syncthreads();
            if (i + 1 < HSTEP) MLA_ISSUE(i + 1, (i + 1) & 1);
#pragma unroll
            for (int t = 0; t < 2; ++t) {
                const LAS unsigned char* tb = F.lds + RING_OFF + (i & 1) * STAGE + t * TILEB + lane * 16;
                f32x16 s;
#pragma unroll
                for (int j = 0; j < 16; ++j) s[j] = 0.f;
#pragma unroll
                for (int kk = 0; kk < 12; ++kk) { const bf16x8 kf = *(const LAS bf16x8*)(tb + kk * 1024); s = MFMA32(kf, qf[kk], s); }
                mla_softmax_pv(s, tb + 12288, m, lsum, o, C_MLA);
            }
        }
#undef MLA_ISSUE
        float* mg = ppart + ((size_t)pair * 8 + F.wave) * (66 * 64) + lane; asm volatile("" : "+v"(mg));
        if (kz == 1) {
#pragma unroll
            for (int db = 0; db < 4; ++db)
#pragma unroll
                for (int i = 0; i < 16; ++i) mg[(db * 16 + i) * 64] = o[db][i];
            mg[64 * 64] = m; mg[65 * 64] = lsum;
            VM_WAIT(); __syncthreads();
            if (F.wave == 0 && lane == 0) { __builtin_amdgcn_fence(__ATOMIC_RELEASE, "agent"); VM_WAIT(); (void)__hip_atomic_fetch_add(pflag + 16 * pair, 1u, __ATOMIC_RELAXED, __HIP_MEMORY_SCOPE_AGENT); }
        } else {
            if (F.wave == 0) { unsigned sp = 0u;
                while ((unsigned)__builtin_amdgcn_readfirstlane(__hip_atomic_load(pflag + 16 * pair, __ATOMIC_RELAXED, __HIP_MEMORY_SCOPE_AGENT)) < (unsigned)(l + 1) * ATT_REP1) { __builtin_amdgcn_s_sleep(2); if (++sp > (1u << 20)) break; }
                __builtin_amdgcn_fence(__ATOMIC_ACQUIRE, "agent"); }
            VM_WAIT(); __syncthreads();
            const float m1 = mg[64 * 64], l1 = mg[65 * 64]; const float mn = fmaxf(m, m1); const float a0 = __builtin_amdgcn_exp2f(m - mn), a1 = __builtin_amdgcn_exp2f(m1 - mn);
            lsum = lsum * a0 + l1 * a1;
#pragma unroll
            for (int db = 0; db < 4; ++db)
#pragma unroll
                for (int i = 0; i < 16; ++i) o[db][i] = o[db][i] * a0 + mg[(db * 16 + i) * 64] * a1;
            attn_store<128>(o, lsum, MIX + (size_t)(b * SEQ + tq) * DM + hd * 128, h);
        }
    }
    const int nu64 = 512 + (do_ctx ? 32 : 0);
    for (int rep2 = 0; rep2 < ATT_REP2; ++rep2)
    for (int u = blockIdx.x; u < nu64; u += gridDim.x) {
        U64 U;
        if (u < 256) {
            const int b = u >> 7, kvh = (u >> 6) & 1, qblk = u & 63; const int hq = kvh * 4 + (F.wave & 3), q0 = qblk * 64 + (F.wave >> 2) * 32;
            U.qrow = QS + ((size_t)(b * 8 + hq) * NKEY + q0 + ql) * 64; U.Kb = KS + (size_t)(b * 2 + kvh) * NKEY * 64; U.Vb = VS + (size_t)(b * 2 + kvh) * 64 * NKEY;
            U.lstart = max(qblk * 64 - 128, 0); U.nloc = (min(qblk * 64 + 191, SEQ - 1) - U.lstart) / 64 + 1;
            U.mode = 1; U.p0 = q0; U.p1 = 0; U.lo = q0 - 128 - 31; U.hi = q0 + 31 + 128; U.coloff = 0; U.rpb = nullptr;
            U.m0 = inp(F, I_SINK)[l * 8 + hq] * LOG2E; U.l0 = 1.f; U.orow = MIX + (size_t)(b * SEQ + q0 + ql) * DM + 1024 + hq * 64;
        } else if (u < 512) {
            const int w = u - 256; const int b = w >> 7, hd = (w >> 4) & 7, rblk = w & 15; const int r = rblk * 4 + (F.wave >> 2) * 2, cb = F.wave & 3;
            const int tq = (r + (ql >> 4)) * 64 + cb * 16 + (ql & 15);
            U.qrow = QN_ + ((size_t)(b * 8 + hd) * NKEY + tq) * 64; U.Kb = KN_ + (size_t)(b * 8 + hd) * NKEY * 64; U.Vb = VN_ + (size_t)(b * 8 + hd) * 64 * NKEY;
            const int ramin = min(max(rblk * 4 - 4, 0), 56), rbmax = min(max(rblk * 4 + 3 - 4, 0), 56) + 7;
            U.lstart = ramin * 64; U.nloc = rbmax - ramin + 1;
            U.mode = 2; U.p0 = r; U.p1 = cb; U.lo = min(max(r - 4, 0), 56); U.hi = min(max(r + 1 - 4, 0), 56) + 7; U.coloff = min(max(cb * 16 - 8, 0), 32);
            U.rpb = inp(F, I_RPB) + ((size_t)l * 8 + hd) * 15 * 31; U.m0 = -1e30f; U.l0 = 0.f; U.orow = MIX + (size_t)(b * SEQ + tq) * DM + 1536 + hd * 64;
        } else if (u < 528) {
            const int w = u - 512; const int b = w >> 3, kvh = (w >> 2) & 1, qblk = w & 3; const int hq = kvh * 4 + (F.wave & 3), q0 = qblk * 64 + (F.wave >> 2) * 32;
            U.qrow = QS + ((size_t)(b * 8 + hq) * NKEY + SEQ + q0 + ql) * 64; U.Kb = KS + (size_t)(b * 2 + kvh) * NKEY * 64; U.Vb = VS + (size_t)(b * 2 + kvh) * 64 * NKEY;
            U.lstart = 0; U.nloc = 0; U.mode = 0; U.p0 = 0; U.p1 = 0; U.lo = 0; U.hi = 0; U.coloff = 0; U.rpb = nullptr;
            U.m0 = inp(F, I_SINK)[l * 8 + hq] * LOG2E; U.l0 = 1.f; U.orow = MIX + (size_t)(NLAT + b * CTXL + q0 + ql) * DM + 1024 + hq * 64;
        } else {
            const int w = u - 528; const int b = w >> 3, hd = w & 7; const int q0 = F.wave * 32;
            U.qrow = QN_ + ((size_t)(b * 8 + hd) * NKEY + SEQ + q0 + ql) * 64; U.Kb = KN_ + (size_t)(b * 8 + hd) * NKEY * 64; U.Vb = VN_ + (size_t)(b * 8 + hd) * 64 * NKEY;
            U.lstart = 0; U.nloc = 0; U.mode = 0; U.p0 = 0; U.p1 = 0; U.lo = 0; U.hi = 0; U.coloff = 0; U.rpb = nullptr;
            U.m0 = -1e30f; U.l0 = 0.f; U.orow = MIX + (size_t)(NLAT + b * CTXL + q0 + ql) * DM + 1536 + hd * 64;
        }
        run_wg64(F, U, h, ql);
    }
    if (do_ctx) for (int u = F.gw; u < 64; u += F.ngw) {
        const int b = u >> 5, hd = (u >> 3) & 3, qt = u & 7; const int bh = b * 4 + hd; const int kq = SEQ + qt * 32 + ql;
        bf16x8 qf[12]; load_q<192>(qf, QM + ((size_t)bh * NKEY + kq) * 192, h);
        f32x16 o[4]; zero_o<128>(o); float m = -1e30f, lsum = 0.f;
        const unsigned char* kimg = KI + (size_t)bh * KIMG_BH + lane * 16; const unsigned char* vimg = VI + (size_t)bh * VIMG_BH + lane * 16;
        for (int t = SEQ / 32; t < NKEY / 32; ++t) {
            f32x16 s;
#pragma unroll
            for (int j = 0; j < 16; ++j) s[j] = 0.f;
#pragma unroll
            for (int kk = 0; kk < 12; ++kk) { const bf16x8 kf = *(const bf16x8*)(kimg + (size_t)t * 12288 + kk * 1024); s = MFMA32(kf, qf[kk], s); }
            bf16x8 vf[2][4];
#pragma unroll
            for (int st = 0; st < 2; ++st)
#pragma unroll
                for (int db = 0; db < 4; ++db) vf[st][db] = *(const bf16x8*)(vimg + (size_t)t * 8192 + (st * 4 + db) * 1024);
            attn_softmax_pv<128>(s, vf, m, lsum, o, C_MLA);
        }
        attn_store<128>(o, lsum, MIX + (size_t)(NLAT + b * CTXL + qt * 32 + ql) * DM + hd * 128, h);
    }
}

DI void convfix_phase(const Args& a, Frame& F, int l, int nrows) {
    const float* RAW = (const float*)(a.ws + WS_RAW); bf16* G = (bf16*)(a.ws + WS_G);
    const float* cw = inp(F, I_CONVW) + (size_t)l * 3 * FF2; const float* cb = inp(F, I_CONVB) + (size_t)l * FF2;
    const int ntile = nrows / 256; const int gt = F.gw * 64 + F.lane, ngt = F.ngw * 64;
    for (int it = gt; it < ntile * 2 * (FF / 4); it += ngt) {
        const int c = (it % (FF / 4)) * 4, e = (it / (FF / 4)) & 1, pm = it / (2 * (FF / 4));
        const bool seq_start = (pm == 0) || (pm == 16) || (pm >= 32), seq_end = (pm == 15) || (pm == 31) || (pm >= 32);
        const float* r0 = RAW + (size_t)pm * 4 * FF2;
        const float* pr = e == 0 ? (seq_start ? nullptr : r0 - 4 * FF2 + 3 * FF2) : r0 + 2 * FF2;
        const float* cr = e == 0 ? r0 : r0 + 3 * FF2;
        const float* nr = e == 0 ? r0 + FF2 : (seq_end ? nullptr : r0 + 4 * FF2);
        const f32x4 z = {0.f, 0.f, 0.f, 0.f};
        const f32x4 pg = pr ? *(const f32x4*)(pr + c) : z, pv = pr ? *(const f32x4*)(pr + FF + c) : z;
        const f32x4 cg = *(const f32x4*)(cr + c), cv = *(const f32x4*)(cr + FF + c);
        const f32x4 ng = nr ? *(const f32x4*)(nr + c) : z, nv = nr ? *(const f32x4*)(nr + FF + c) : z;
        const f32x4 gg = pg * *(const f32x4*)(cw + c) + cg * *(const f32x4*)(cw + FF2 + c) + ng * *(const f32x4*)(cw + 2 * FF2 + c) + *(const f32x4*)(cb + c);
        const f32x4 vv = pv * *(const f32x4*)(cw + FF + c) + cv * *(const f32x4*)(cw + FF2 + FF + c) + nv * *(const f32x4*)(cw + 2 * FF2 + FF + c) + *(const f32x4*)(cb + FF + c);
        v2u o; o.x = pk2(silu_f(gg.x) * vv.x, silu_f(gg.y) * vv.y); o.y = pk2(silu_f(gg.z) * vv.z, silu_f(gg.w) * vv.w);
        *(v2u*)(G + (size_t)(pm * 256 + (e ? 255 : 0)) * FF + c) = o;
    }
}

#ifndef G_ABL
#define G_ABL 0
#endif
constexpr int PH_PER_LAYER = 11, N_PHASES = 1 + DEPTH * PH_PER_LAYER;
__global__ void __launch_bounds__(NTHREADS, 2) mega_fwd(Args args) {
    extern __shared__ __attribute__((aligned(16))) unsigned char lds_raw[];
    Frame F;
    F.lds = (LAS unsigned char*)lds_raw;
    const int wave0 = __builtin_amdgcn_readfirstlane((int)threadIdx.x >> 6);
    F.lane = fresh_lane(); F.wave = wave0; F.tid = wave0 * 64 + F.lane;
    F.gw = blockIdx.x * NWAVES + F.wave; F.ngw = gridDim.x * NWAVES;
    volatile LAS unsigned* MISC = (volatile LAS unsigned*)(F.lds + MISC_OFF);
    for (int u = F.tid; u < (PTAB_OFF - LDSCTL_OFF) / 4; u += NTHREADS) ((LAS unsigned*)(F.lds + LDSCTL_OFF))[u] = 0u;
    if (F.tid < N_IN) *(LAS unsigned long long*)(F.lds + PTAB_OFF + 8 * F.tid) = (unsigned long long)args.in[F.tid];
    __syncthreads();
    unsigned char* ws = args.ws;
    const int lo = args.ph_lo, hi = args.ph_hi;
    XcdBarrier bar; bar.bar = (unsigned*)(ws + WS_CTL) + CW_BAR; bar.x = 0; bar.st = nullptr; bar.w0 = wave0;
    if (hi - lo > 1) bar = xcd_barrier_post((unsigned*)(ws + WS_CTL) + CW_BAR, MISC + 8, wave0);
#ifndef PH_MASK
#define PH_MASK 0xFFF
#endif
#define PHEN(j) ((((PH_MASK) >> (j)) & 1) != 0)
#ifndef PH_DUP
#define PH_DUP 0
#endif
#define NREP(j) (1 + (((PH_DUP) >> (j)) & 1))
#define IN(k) (lo <= (k) && (k) < hi)
#define FRESH() do { F.lane = fresh_lane(); F.wave = wave0; F.tid = wave0 * 64 + F.lane; F.gw = blockIdx.x * NWAVES + wave0; } while (0)
#define SEAM(k) do { if (IN(k) && IN((k) + 1)) xcd_barrier(bar); } while (0)

    if (PHEN(0) && IN(0)) for (int rep = 0; rep < NREP(0); ++rep) { FRESH(); p0_prologue(args, F, rep); } SEAM(0);

    for (int l = 0; l < DEPTH; ++l) {
        const int p0 = 1 + l * PH_PER_LAYER;
        const bool upd = l < DEPTH - 1;
        const int mrows = upd ? NROW : NLAT;
        const float* xlat = l == 0 ? inp(F, I_X) : (const float*)(ws + WS_X);
        const float* xctx = l == 0 ? inp(F, I_CTX) : (const float*)(ws + WS_X) + (size_t)NLAT * DM;
        float* xo_lat = (float*)(ws + WS_X); float* xo_ctx = (float*)(ws + WS_X) + (size_t)NLAT * DM;
        const float* modl = (const float*)(ws + WS_MOD) + (size_t)l * 3 * 12288;
        bf16* H = (bf16*)(ws + WS_H);
        float* slab = (float*)(ws + WS_SLAB);
        float* dummy = (float*)(ws + WS_AUP);
        if (PHEN(1) && IN(p0 + 0)) for (int rep = 0; rep < NREP(1); ++rep) { FRESH(); norm_phase(F, xlat, xctx, inp(F, I_GMIX) + l * DM, modl, 0, 1, H, NROW, slab, l > 0 ? 11 : 0, modl - 3 * 12288 + 2 * 12288 + 5 * DM, xo_ctx); } SEAM(p0 + 0);
        if (PHEN(2) && IN(p0 + 1)) for (int rep = 0; rep < NREP(2); ++rep) { FRESH(); pg8::Gemm g{H, (const bf16*)(ws + WS_WIN) + (size_t)l * INP * DM, NROW, INP, DM, DM}; pg8::StaticOrder S; S.init(NROW, INP, gridDim.x, (int)blockIdx.x);
            pg8::EpiBf16S E{(bf16*)(ws + WS_P), INP, 0, nullptr};
            pg8::gemm_phase<pg8::EpiBf16S, pg8::StaticOrder, true, true>(F.lds + RING_OFF, g, S, E, wave0); } SEAM(p0 + 1);
        if (PHEN(3) && IN(p0 + 2)) for (int rep = 0; rep < NREP(3); ++rep) { FRESH(); prep_phase(args, F, l, rep); } SEAM(p0 + 2);
        if (PHEN(4) && IN(p0 + 3)) for (int rep = 0; rep < NREP(4); ++rep) { FRESH();
            { pg8::Gemm g{(const bf16*)(ws + WS_QN), (const bf16*)(ws + WS_WQB) + (size_t)l * 768 * 512, NROW, 768, 512, 512}; pg8::StaticOrder S; S.init(NROW, 768, gridDim.x, (int)blockIdx.x);
              pg8::EpiBf16S E{(bf16*)(ws + WS_QRAW), 768, 0, nullptr}; pg8::gemm_phase<pg8::EpiBf16S, pg8::StaticOrder, true, true>(F.lds + RING_OFF, g, S, E, wave0); }
            { pg8::Gemm g{(const bf16*)(ws + WS_KVN), (const bf16*)(ws + WS_WKVB) + (size_t)l * 1024 * 256, NROW, 1024, 256, 256}; pg8::StaticOrder S; S.init(NROW, 1024, gridDim.x, (int)((blockIdx.x + gridDim.x - 102 % gridDim.x) % gridDim.x));
              pg8::EpiBf16S E{(bf16*)(ws + WS_KVRAW), 1024, 0, nullptr}; pg8::gemm_phase<pg8::EpiBf16S, pg8::StaticOrder, true, true>(F.lds + RING_OFF, g, S, E, wave0); }
            { pg8::Gemm g{(const bf16*)(ws + WS_WOP) + (size_t)l * DM * 512, (const bf16*)(ws + WS_WPOOL) + (size_t)l * 512 * 512, DM, 512, 512, 512}; pg8::StaticOrder S; S.init(DM, 512, gridDim.x, (int)((blockIdx.x + gridDim.x - 238 % gridDim.x) % gridDim.x));
              pg8::EpiBf16S E{(bf16*)(ws + WS_WOUT) + (size_t)l * DM * DM, DM, 512, nullptr}; pg8::gemm_phase<pg8::EpiBf16S, pg8::StaticOrder, true, true>(F.lds + RING_OFF, g, S, E, wave0); }
        } SEAM(p0 + 3);
        if (PHEN(5) && IN(p0 + 4)) for (int rep = 0; rep < NREP(5); ++rep) { FRESH(); post_phase(args, F, l); } SEAM(p0 + 4);
        if (PHEN(6) && IN(p0 + 5)) for (int rep = 0; rep < NREP(6); ++rep) { FRESH(); attn_phase(args, F, l, upd); } SEAM(p0 + 5);
        const bool flow = gridDim.x == 256;
        unsigned* cw_panel = (unsigned*)(ws + WS_CTL) + CW_PANEL; unsigned* cw_ctxc = (unsigned*)(ws + WS_CTL) + CW_CTXC;
        if (PHEN(7) && IN(p0 + 6)) for (int rep = 0; rep < NREP(7); ++rep) { FRESH();
            if (upd && !(rep > 0 && (G_ABL & 1))) { pg8::Gemm g{(const bf16*)(ws + WS_MIX), (const bf16*)(ws + WS_WOUT) + (size_t)l * DM * DM, NROW, DM, 256, DM};
              const int G_ = (int)gridDim.x, rank = ((int)blockIdx.x % 8) * (G_ / 8) + (int)blockIdx.x / 8; pg8::SplitOrder S{32, 2, 8, 8, G_, (G_ % 8 == 0) ? (rank + 128) % G_ : (int)blockIdx.x};
              pg8::EpiSlab E{slab, 32, NCTX, DM};
              pg8::gemm_phase<pg8::EpiSlab, pg8::SplitOrder, true, true>(F.lds + RING_OFF, g, S, E, wave0);
              pg8::Unit uc; if (flow && S.next(0, uc)) count_publish(F, cw_ctxc); }
            { pg8::Gemm g{(const bf16*)(ws + WS_MIX), (const bf16*)(ws + WS_WOUT) + (size_t)l * DM * DM, NLAT, DM, DM, DM}; pg8::StaticOrder S; S.init(NLAT, DM, gridDim.x, (int)blockIdx.x);
              pg8::EpiResid E{xlat, xctx, rep ? dummy : xo_lat, rep ? dummy + (size_t)NLAT * DM : xo_ctx, modl + 2 * DM};
              pg8::gemm_phase<pg8::EpiResid, pg8::StaticOrder, true, true>(F.lds + RING_OFF, g, S, E, wave0);
              pg8::Unit ut; if (flow && S.next(0, ut)) count_publish(F, cw_panel + 16 * ut.pm); } }
        if (!flow) SEAM(p0 + 6);
        if (PHEN(8) && IN(p0 + 7)) for (int rep = 0; rep < NREP(8); ++rep) { FRESH();
            if (flow) { pg8::StaticOrder S; S.init(NLAT, DM, gridDim.x, (int)blockIdx.x); pg8::Unit ut; (void)S.next(0, ut);
                count_wait(F, cw_panel + 16 * ut.pm, 8u * (unsigned)(l + 1));
                norm_phase(F, xo_lat, xctx, inp(F, I_GFFN) + l * DM, modl, 3, 4, H, mrows, slab, upd ? 8 : 0, modl + 2 * 12288 + 2 * DM, xo_ctx, 1, ut.pm * 256 + ut.pn * 32);
                if (upd) { count_wait(F, cw_ctxc, 128u * (unsigned)(l + 1)); norm_phase(F, xo_lat, xctx, inp(F, I_GFFN) + l * DM, modl, 3, 4, H, mrows, slab, 8, modl + 2 * 12288 + 2 * DM, xo_ctx, 2); }
            } else norm_phase(F, xo_lat, xctx, inp(F, I_GFFN) + l * DM, modl, 3, 4, H, mrows, slab, upd ? 8 : 0, modl + 2 * 12288 + 2 * DM, xo_ctx); } SEAM(p0 + 7);
        if (PHEN(9) && IN(p0 + 8)) for (int rep = 0; rep < NREP(9); ++rep) { FRESH(); pg8::Gemm g{H, (const bf16*)(ws + WS_WUP) + (size_t)l * FF2 * DM, mrows, FF2, DM, DM}; pg8::StaticOrder S; S.init(mrows, FF2, gridDim.x, (int)blockIdx.x);
            pg8::EpiConvGate E{(bf16*)(ws + WS_G), (float*)(ws + WS_RAW), inp(F, I_CONVW) + (size_t)l * 3 * FF2, inp(F, I_CONVB) + (size_t)l * FF2, (LAS float*)(F.lds + XB_OFF)};
            pg8::gemm_phase<pg8::EpiConvGate, pg8::StaticOrder, true, true>(F.lds + RING_OFF, g, S, E, wave0); } SEAM(p0 + 8);
        if (PHEN(10) && IN(p0 + 9)) for (int rep = 0; rep < NREP(10); ++rep) { FRESH(); convfix_phase(args, F, l, mrows); } SEAM(p0 + 9);
        if (PHEN(11) && IN(p0 + 10)) for (int rep = 0; rep < NREP(11); ++rep) { FRESH();
            if (upd && !(rep > 0 && (G_ABL & 1))) { pg8::Gemm g{(const bf16*)(ws + WS_G), (const bf16*)(ws + WS_WDN) + (size_t)l * DM * FF, NROW, DM, 512, FF};
              const int G_ = (int)gridDim.x, rank = ((int)blockIdx.x % 8) * (G_ / 8) + (int)blockIdx.x / 8; pg8::SplitOrder S{32, 2, 8, 11, G_, (G_ % 8 == 0) ? (rank + 176) % G_ : (int)blockIdx.x};
              pg8::EpiSlab E{slab, 32, NCTX, DM};
              pg8::gemm_phase<pg8::EpiSlab, pg8::SplitOrder, true, true>(F.lds + RING_OFF, g, S, E, wave0); }
            { pg8::Gemm g{(const bf16*)(ws + WS_G), (const bf16*)(ws + WS_WDN) + (size_t)l * DM * FF, NLAT, DM, FF, FF}; pg8::StaticOrder S; S.init(NLAT, DM, gridDim.x, (int)blockIdx.x);
              pg8::EpiResid E{xo_lat, xo_ctx, rep ? dummy : (upd ? xo_lat : args.out), rep ? dummy + (size_t)NLAT * DM : xo_ctx, modl + 5 * DM};
              pg8::gemm_phase<pg8::EpiResid, pg8::StaticOrder, true, true>(F.lds + RING_OFF, g, S, E, wave0); } } SEAM(p0 + 10);
    }
#undef IN
#undef SEAM
}

#ifndef MK_N_LAUNCHES
#define MK_N_LAUNCHES 1
#endif
extern "C" void kernel_launch(void* const* d_in, const int* in_sizes, int n_in, void* d_out, int out_size, void* d_ws, size_t ws_size, hipStream_t stream) {
    static int grid = 0;
    if (grid == 0) {
        if (n_in != N_IN || out_size != NLAT * DM || ws_size < WS_END) { fprintf(stderr, "kernel_launch: unexpected shapes: n_in %d out %d ws %zu (need %zu)\n", n_in, out_size, ws_size, (size_t)WS_END); grid = -1; return; }
        int dev = 0, cus = 0, per_cu = 0;
        if (hipGetDevice(&dev) != hipSuccess || hipDeviceGetAttribute(&cus, hipDeviceAttributeMultiprocessorCount, dev) != hipSuccess) { grid = -1; return; }
        if (hipFuncSetAttribute((const void*)mega_fwd, hipFuncAttributeMaxDynamicSharedMemorySize, LDS_BYTES) != hipSuccess) { fprintf(stderr, "kernel_launch: hipFuncSetAttribute failed\n"); grid = -1; return; }
        if (hipOccupancyMaxActiveBlocksPerMultiprocessor(&per_cu, (const void*)mega_fwd, NTHREADS, LDS_BYTES) != hipSuccess || per_cu < 1) fprintf(stderr, "kernel_launch: occupancy query reports %d\n", per_cu);
        (void)hipGetLastError();
        grid = cus;
    }
    if (grid < 0) return;
    (void)hipMemsetAsync((char*)d_ws + WS_CTL, 0, CTL_ZERO_BYTES, stream);
    Args a{};
    for (int i = 0; i < N_IN; ++i) a.in[i] = (const float*)d_in[i];
    a.out = (float*)d_out; a.ws = (unsigned char*)d_ws;
    if (MK_N_LAUNCHES == 1) { a.ph_lo = 0; a.ph_hi = N_PHASES; hipLaunchKernelGGL(mega_fwd, dim3(grid), dim3(NTHREADS), LDS_BYTES, stream, a); }
    else for (int p = 0; p < N_PHASES; ++p) { a.ph_lo = p; a.ph_hi = p + 1; hipLaunchKernelGGL(mega_fwd, dim3(grid), dim3(NTHREADS), LDS_BYTES, stream, a); }
}
```

```cpp
#include <hip/hip_runtime.h>
#include <cstdio>
#include <cstdint>

#define DI __device__ __forceinline__
#define GAS __attribute__((address_space(1)))
#define LAS __attribute__((address_space(3)))
typedef unsigned short bf16;
typedef unsigned v4u __attribute__((ext_vector_type(4)));
typedef unsigned v2u __attribute__((ext_vector_type(2)));
typedef float f32x4 __attribute__((ext_vector_type(4)));
typedef float f32x2 __attribute__((ext_vector_type(2)));
typedef float f32x16 __attribute__((ext_vector_type(16)));
typedef short bf16x8 __attribute__((ext_vector_type(8)));
typedef short s16x4 __attribute__((ext_vector_type(4)));
typedef GAS unsigned gu32;
#define RLX_AGENT __ATOMIC_RELAXED, __HIP_MEMORY_SCOPE_AGENT
#define LDS_WAIT() asm volatile("s_waitcnt lgkmcnt(0)" ::: "memory")
#define VM_WAIT() asm volatile("s_waitcnt vmcnt(0)" ::: "memory")
DI int fresh_lane() { int l; asm volatile("v_mbcnt_lo_u32_b32 %0, -1, 0\n\tv_mbcnt_hi_u32_b32 %0, -1, %0" : "=v"(l)); return l; }
DI unsigned f2bf(float f) { unsigned u = __builtin_bit_cast(unsigned, f); return (u + 0x7fffu + ((u >> 16) & 1u)) >> 16; }
DI unsigned pk2(float lo, float hi) { return f2bf(lo) | (f2bf(hi) << 16); }
DI float bf2f(unsigned short b) { return __builtin_bit_cast(float, (unsigned)b << 16); }
DI float bflo(unsigned w) { return __builtin_bit_cast(float, w << 16); }
DI float bfhi(unsigned w) { return __builtin_bit_cast(float, w & 0xffff0000u); }

namespace pg8 {
#define PG8_LAS __attribute__((address_space(3)))
typedef unsigned short bf16_t;
typedef short bf16x8 __attribute__((ext_vector_type(8)));
typedef float f32x4 __attribute__((ext_vector_type(4)));
typedef unsigned u32x4 __attribute__((ext_vector_type(4)));
constexpr int BM = 256, BK = 64, HALF = 128, HTB = HALF * BK * 2  , STAGE_BYTES = 8 * HTB, NXCD = 8, WGM = 8;

__host__ __device__ __forceinline__ int lds_byte(int r, int c) { const int st = (r >> 4) * 2 + (c >> 5), rr = r & 15, cc = c & 31, ob = rr * 64 + cc * 2; return st * 1024 + (ob ^ (((ob >> 9) & 1) << 5)); }
__host__ __device__ __forceinline__ void stage_rc(int b, int& R, int& C) { const int st = b / 1024, sb = b % 1024, swz = sb ^ (((sb >> 9) & 1) << 5); R = (st >> 1) * 16 + swz / 64; C = (st & 1) * 32 + (swz % 64) / 2; }
__host__ __device__ __forceinline__ int perm32(int rho) { const int n = rho >> 4, i = rho & 15; return 8 * (i >> 2) + 4 * n + (i & 3); }

struct Unit { int pm, pn, pk; };
struct Gemm { const bf16_t* A; const bf16_t* Bt; int M, N, K, ld; };

struct StaticOrder {
    int nM, nN, nwg, G, c;
    __host__ __device__ void init(int M, int N, int G_, int c_) { nM = M / BM; nN = N / BM; nwg = nM * nN; G = G_; c = c_; }
    __host__ __device__ bool next(int i, Unit& u) const {
        const long L = (long)i * G + c; if (L >= nwg) return false;
        int wgid = (int)L; { const int q = nwg / NXCD, r = nwg % NXCD, xcd = wgid % NXCD, off = wgid / NXCD; wgid = (xcd < r ? xcd * (q + 1) : r * (q + 1) + (xcd - r) * q) + off; }
        const int nig = WGM * nN, gid = wgid / nig, fm = gid * WGM, gsz = (nM - fm) < WGM ? (nM - fm) : WGM;
        u.pm = fm + ((wgid % nig) % gsz); u.pn = (wgid % nig) / gsz; u.pk = 0; return true;
    }
    __device__ __forceinline__ void a_ready(const Unit&) const {}
    __device__ __forceinline__ void done(const Unit&) const {}
};

__device__ __forceinline__ unsigned cvt_pk_bf16(float lo, float hi) { unsigned r; asm volatile("v_cvt_pk_bf16_f32 %0, %1, %2" : "=v"(r) : "v"(lo), "v"(hi)); return r; }
typedef float f32x2 __attribute__((ext_vector_type(2)));
struct EpiBf16S {
    static constexpr bool PERM = true, AFTER_DRAIN = false, PERMA = false;
    bf16_t* O; int ldc; int coff; const float* cscale;
    __device__ __forceinline__ void operator()(const f32x4 (&acc)[2][2][4][2], const Unit& u, int wr, int wc, int fr, int fq) const {
        const int row0 = u.pm * BM + wr * 64 + fr; const int col0 = u.pn * BM + wc * 32 + 8 * fq;
        f32x4 sv[2][2];
#pragma unroll
        for (int bj = 0; bj < 2; ++bj)
#pragma unroll
            for (int n = 0; n < 2; ++n) sv[bj][n] = cscale ? *(const f32x4*)(cscale + col0 + bj * HALF + 4 * n) : (f32x4){1.f, 1.f, 1.f, 1.f};
#pragma unroll
        for (int ai = 0; ai < 2; ++ai)
#pragma unroll
            for (int m = 0; m < 4; ++m) { bf16_t* rowp = O + (size_t)(row0 + ai * HALF + m * 16) * ldc + coff + col0;
#pragma unroll
                for (int bj = 0; bj < 2; ++bj) { const f32x4 v0 = acc[ai][bj][m][0] * sv[bj][0], v1 = acc[ai][bj][m][1] * sv[bj][1];
                    u32x4 w; w.x = cvt_pk_bf16(v0[0], v0[1]); w.y = cvt_pk_bf16(v0[2], v0[3]); w.z = cvt_pk_bf16(v1[0], v1[1]); w.w = cvt_pk_bf16(v1[2], v1[3]);
                    *(u32x4*)(rowp + bj * HALF) = w; } }
    }
};
struct EpiResid {
    static constexpr bool PERM = false, AFTER_DRAIN = false, PERMA = false;
    const float* blat; const float* bctx; float* olat; float* octx; const float* gate;
    __device__ __forceinline__ void operator()(const f32x4 (&acc)[2][2][4][2], const Unit& u, int wr, int wc, int fr, int fq) const {
        const int row0 = u.pm * BM + wr * 64 + fr, col0 = u.pn * BM + wc * 32 + 4 * fq;
        const int bid = u.pm < 16 ? 0 : (u.pm < 32 ? 1 : 2);
        const float* gp = gate + (size_t)bid * 12288 + col0;
        const float* bs = u.pm < 32 ? blat : bctx - (size_t)8192 * 2048;
        float* os = u.pm < 32 ? olat : octx - (size_t)8192 * 2048;
        f32x4 gv[2][2];
#pragma unroll
        for (int bj = 0; bj < 2; ++bj)
#pragma unroll
            for (int n = 0; n < 2; ++n) gv[bj][n] = *(const f32x4*)(gp + bj * HALF + n * 16);
#pragma unroll
        for (int ai = 0; ai < 2; ++ai)
#pragma unroll
            for (int m = 0; m < 4; ++m) { const size_t ro = (size_t)(row0 + ai * HALF + m * 16) * 2048 + col0;
                if (m & 1) asm volatile("" ::: "memory");
#pragma unroll
                for (int bj = 0; bj < 2; ++bj)
#pragma unroll
                    for (int n = 0; n < 2; ++n) { const f32x4 b = *(const f32x4*)(bs + ro + bj * HALF + n * 16);
                        *(f32x4*)(os + ro + bj * HALF + n * 16) = b + gv[bj][n] * acc[ai][bj][m][n]; } }
    }
};
struct SplitOrder {
    int pm0, nM, nN, nS, G, c;
    __device__ bool next(int i, Unit& u) const { const long L = (long)i * G + c; if (L >= (long)nM * nN * nS) return false; const int q = (int)L;
        u.pk = q % nS; u.pn = (q / nS) % nN; u.pm = pm0 + q / (nS * nN); return true; }
    __device__ __forceinline__ void a_ready(const Unit&) const {}
    __device__ __forceinline__ void done(const Unit&) const {}
};
struct EpiResidNorm {
    static constexpr bool PERM = true, AFTER_DRAIN = true, PERMA = false;
    const float* blat; float* olat; const float* gate;
    const float* gain; const float* msh; const float* msc;
    bf16_t* H; unsigned* xbuf; unsigned* cnt; unsigned want;
    __device__ __forceinline__ void fused(f32x4 (&acc)[2][2][4][2], const Unit& u, int wr, int wc, int fr, int fq, PG8_LAS unsigned char* lds, int wid, int) const {
        const int row0 = u.pm * BM + wr * 64 + fr, col0 = u.pn * BM + wc * 32 + 8 * fq;
        const int bid = u.pm < 16 ? 0 : 1;
        { const float* gp = gate + (size_t)bid * 12288 + col0;
          f32x4 gv[2][2];
#pragma unroll
          for (int bj = 0; bj < 2; ++bj)
#pragma unroll
              for (int n = 0; n < 2; ++n) gv[bj][n] = *(const f32x4*)(gp + bj * HALF + n * 4);
#pragma unroll
          for (int ai = 0; ai < 2; ++ai)
#pragma unroll
              for (int m = 0; m < 4; ++m) { const size_t ro = (size_t)(row0 + ai * HALF + m * 16) * 2048 + col0;
                  if (m == 0 && ai == 1) asm volatile("" ::: "memory");
#pragma unroll
                  for (int bj = 0; bj < 2; ++bj)
#pragma unroll
                      for (int n = 0; n < 2; ++n) { const f32x4 b = *(const f32x4*)(blat + ro + bj * HALF + n * 4);
                          acc[ai][bj][m][n] = b + gv[bj][n] * acc[ai][bj][m][n]; }
                  asm volatile("" : "+v"(acc[ai][0][m][0]), "+v"(acc[ai][0][m][1]), "+v"(acc[ai][1][m][0]), "+v"(acc[ai][1][m][1]));
              } }
        PG8_LAS float* P = (PG8_LAS float*)lds; PG8_LAS float* S = (PG8_LAS float*)(lds + 8192);
        const int lane = fresh_lane();
#pragma unroll
        for (int ai = 0; ai < 2; ++ai)
#pragma unroll
            for (int m = 0; m < 4; ++m) { float s = 0.f;
#pragma unroll
                for (int bj = 0; bj < 2; ++bj)
#pragma unroll
                    for (int n = 0; n < 2; ++n) { const f32x4 x = acc[ai][bj][m][n]; s += (x[0] * x[0] + x[1] * x[1]) + (x[2] * x[2] + x[3] * x[3]); }
                s += __builtin_bit_cast(float, __builtin_amdgcn_ds_bpermute((lane ^ 16) << 2, __builtin_bit_cast(int, s))); s += __builtin_bit_cast(float, __builtin_amdgcn_ds_bpermute((lane ^ 32) << 2, __builtin_bit_cast(int, s)));
                if (fq == 0) P[(ai * HALF + wr * 64 + m * 16 + fr) * 4 + wc] = s; }
        asm volatile("s_waitcnt lgkmcnt(0)" ::: "memory"); __builtin_amdgcn_s_barrier(); asm volatile("" ::: "memory");
        const int row = wid * 32 + (lane & 31);
        if (lane < 32) { const f32x4 p = *(const PG8_LAS f32x4*)(P + row * 4); const float t = (p[0] + p[1]) + (p[2] + p[3]);
            __hip_atomic_store(xbuf + (size_t)(u.pm * BM + row) * 8 + u.pn, __builtin_bit_cast(unsigned, t), __ATOMIC_RELAXED, __HIP_MEMORY_SCOPE_AGENT); }
        asm volatile("s_waitcnt vmcnt(0)" ::: "memory");
        if (lane == 0) __hip_atomic_fetch_add(cnt + 16 * u.pm, 1u, __ATOMIC_RELAXED, __HIP_MEMORY_SCOPE_AGENT);
        { int r0s = row0; asm volatile("" : "+v"(r0s));
#pragma unroll
          for (int ai = 0; ai < 2; ++ai)
#pragma unroll
              for (int m = 0; m < 4; ++m) { float* op = olat + (size_t)(r0s + ai * HALF + m * 16) * 2048 + col0; asm volatile("" : "+v"(op));
#pragma unroll
                  for (int bj = 0; bj < 2; ++bj)
#pragma unroll
                      for (int n = 0; n < 2; ++n) *(f32x4*)(op + bj * HALF + n * 4) = acc[ai][bj][m][n]; } }
        if (wid == 0) {
            unsigned sp = 0u;
            while ((unsigned)__builtin_amdgcn_readfirstlane(__hip_atomic_load(cnt + 16 * u.pm, __ATOMIC_RELAXED, __HIP_MEMORY_SCOPE_AGENT)) < want) { __builtin_amdgcn_s_sleep(2); if (++sp > (1u << 20)) break; }
            __builtin_amdgcn_fence(__ATOMIC_ACQUIRE, "agent");
        }
        asm volatile("s_waitcnt vmcnt(0) lgkmcnt(0)" ::: "memory"); __builtin_amdgcn_s_barrier(); asm volatile("" ::: "memory");
        if (lane < 32) { const unsigned* sl = xbuf + (size_t)(u.pm * BM + row) * 8; float q = 0.f;
#pragma unroll
            for (int t = 0; t < 8; ++t) q += __builtin_bit_cast(float, __hip_atomic_load(sl + t, __ATOMIC_RELAXED, __HIP_MEMORY_SCOPE_AGENT));
            S[row] = __builtin_amdgcn_rsqf(q * (1.0f / 2048.0f) + 1e-6f); }
        f32x4 ga0, ga1, sb0, sb1, na0, na1, nb0, nb1;
        { const int c = col0; const float* mc = msc + (size_t)bid * 12288 + c; const float* mh = msh + (size_t)bid * 12288 + c;
          na0 = *(const f32x4*)(gain + c) * (*(const f32x4*)mc + 1.0f); na1 = *(const f32x4*)(gain + c + 4) * (*(const f32x4*)(mc + 4) + 1.0f); nb0 = *(const f32x4*)mh; nb1 = *(const f32x4*)(mh + 4); }
        asm volatile("s_waitcnt lgkmcnt(0)" ::: "memory"); __builtin_amdgcn_s_barrier(); asm volatile("" ::: "memory");
#pragma unroll
        for (int bj = 0; bj < 2; ++bj) { const int c = col0 + bj * HALF;
            ga0 = na0; ga1 = na1; sb0 = nb0; sb1 = nb1;
            asm volatile("" ::: "memory");
            if (bj == 0) { const int c2 = col0 + HALF; const float* mc = msc + (size_t)bid * 12288 + c2; const float* mh = msh + (size_t)bid * 12288 + c2;
                na0 = *(const f32x4*)(gain + c2) * (*(const f32x4*)mc + 1.0f); na1 = *(const f32x4*)(gain + c2 + 4) * (*(const f32x4*)(mc + 4) + 1.0f); nb0 = *(const f32x4*)mh; nb1 = *(const f32x4*)(mh + 4); }
#pragma unroll
            for (int ai = 0; ai < 2; ++ai)
#pragma unroll
                for (int m = 0; m < 4; ++m) { const int r = ai * HALF + wr * 64 + m * 16 + fr; const float rs = S[r];
                    const f32x4 y0 = (acc[ai][bj][m][0] * rs) * ga0 + sb0, y1 = (acc[ai][bj][m][1] * rs) * ga1 + sb1;
                    u32x4 w; w.x = cvt_pk_bf16(y0[0], y0[1]); w.y = cvt_pk_bf16(y0[2], y0[3]); w.z = cvt_pk_bf16(y1[0], y1[1]); w.w = cvt_pk_bf16(y1[2], y1[3]);
                    *(u32x4*)(H + (size_t)(u.pm * BM + r) * 2048 + c) = w; } }
        asm volatile("s_waitcnt lgkmcnt(0)" ::: "memory"); __builtin_amdgcn_s_barrier();
    }
};
struct EpiSlab {
    static constexpr bool PERM = false, AFTER_DRAIN = false, PERMA = false;
    float* slab; int pm0, nrows, ldc;
    __device__ __forceinline__ void operator()(const f32x4 (&acc)[2][2][4][2], const Unit& u, int wr, int wc, int fr, int fq) const {
        const int row0 = (u.pm - pm0) * BM + wr * 64 + fr, col0 = u.pn * BM + wc * 32 + 4 * fq;
        float* base = slab + (size_t)u.pk * nrows * ldc;
#pragma unroll
        for (int ai = 0; ai < 2; ++ai)
#pragma unroll
            for (int m = 0; m < 4; ++m) { float* rowp = base + (size_t)(row0 + ai * HALF + m * 16) * ldc + col0;
#pragma unroll
                for (int bj = 0; bj < 2; ++bj)
#pragma unroll
                    for (int n = 0; n < 2; ++n) *(f32x4*)(rowp + bj * HALF + n * 16) = acc[ai][bj][m][n]; }
    }
};
template <int CTRL> __device__ __forceinline__ float dpp_ror(float x) { return __builtin_bit_cast(float, __builtin_amdgcn_update_dpp(0, __builtin_bit_cast(int, x), CTRL, 0xf, 0xf, false)); }
struct EpiConvGate {
    static constexpr bool PERM = true, AFTER_DRAIN = false, PERMA = true;
    bf16_t* G; float* RAW; const float* cw; const float* cb; PG8_LAS float* XB;
    __device__ __forceinline__ void operator()(const f32x4 (&acc)[2][2][4][2], const Unit& u, int wr, int wc, int fr, int fq) const {
        const int lane = fq * 16 + fr, wid = wr * 4 + wc;
        const int gcol = u.pn * 128 + wc * 32 + 8 * fq;
        float wv[2];
        { const int t = wid * 64 + lane;
#pragma unroll
          for (int q = 0; q < 2; ++q) { const int e = t + 512 * q, k = e >> 8, c = e & 255; const int oc = (c >> 7) * 5632 + u.pn * 128 + (c & 127);
              wv[q] = k < 3 ? cw[(size_t)k * 11264 + oc] : cb[oc]; } }
        if (fr == 0 || fr == 15) { const int e = fr == 0 ? 0 : 1, m = fr == 0 ? 0 : 3;
#pragma unroll
            for (int ai = 0; ai < 2; ++ai) { PG8_LAS float* p = XB + ((wid * 2 + ai) * 2 + e) * 64 + fq * 16;
#pragma unroll
                for (int bj = 0; bj < 2; ++bj)
#pragma unroll
                    for (int n = 0; n < 2; ++n) *(PG8_LAS f32x4*)(p + bj * 8 + n * 4) = (m == 0 ? acc[ai][bj][0][n] : acc[ai][bj][3][n]); } }
        { PG8_LAS float* WL = XB + 2048; const int t = wid * 64 + lane; WL[t] = wv[0]; WL[t + 512] = wv[1]; }
        asm volatile("s_waitcnt vmcnt(0) lgkmcnt(0)\n\ts_barrier" ::: "memory");
        { const bool top = (wr == 0) && (fr == 0), bot = (wr == 1) && (fr == 15);
          if (top || bot) { float* rp = RAW + ((size_t)u.pm * 4 + (top ? 0 : 2)) * 11264 + gcol;
#pragma unroll
              for (int bj = 0; bj < 2; ++bj)
#pragma unroll
                  for (int n = 0; n < 2; ++n) { *(f32x4*)(rp + bj * 5632 + n * 4) = (top ? acc[0][bj][0][n] : acc[1][bj][2][n]);
                                                *(f32x4*)(rp + 11264 + bj * 5632 + n * 4) = (top ? acc[0][bj][1][n] : acc[1][bj][3][n]); } } }
        typedef unsigned u32x2 __attribute__((ext_vector_type(2)));
        u32x2 keep[2][4];
#pragma unroll
        for (int n = 0; n < 2; ++n) {
#pragma unroll
            for (int ai = 0; ai < 2; ++ai) {
                asm volatile("" ::: "memory");
                const PG8_LAS float* wl = XB + 2048 + wc * 32 + 8 * fq + 4 * n;
                const bool has_up = !(wr == 0 && ai == 0), has_dn = !(wr == 1 && ai == 1);
                const int w_up = wr == 1 ? wc : 4 + wc, a_up = wr == 1 ? ai : ai - 1, w_dn = wr == 0 ? 4 + wc : wc, a_dn = wr == 0 ? ai : ai + 1;
                const PG8_LAS float* pu = XB + ((w_up * 2 + a_up) * 2 + 1) * 64 + fq * 16 + n * 4;
                const PG8_LAS float* pd = XB + ((w_dn * 2 + a_dn) * 2 + 0) * 64 + fq * 16 + n * 4;
                f32x4 sg[4];
                { const f32x4 w0 = *(const PG8_LAS f32x4*)wl, w1 = *(const PG8_LAS f32x4*)(wl + 256), w2 = *(const PG8_LAS f32x4*)(wl + 512), bb = *(const PG8_LAS f32x4*)(wl + 768);
                  f32x4 hu = {0.f, 0.f, 0.f, 0.f}, hd = hu;
                  if (has_up) hu = *(const PG8_LAS f32x4*)pu;
                  if (has_dn) hd = *(const PG8_LAS f32x4*)pd;
                  f32x4 p0, n3;
#pragma unroll
                  for (int j = 0; j < 4; ++j) { const float t = dpp_ror<0x121>(acc[ai][0][3][n][j]), d = dpp_ror<0x12F>(acc[ai][0][0][n][j]); p0[j] = fr == 0 ? hu[j] : t; n3[j] = fr == 15 ? hd[j] : d; }
#pragma unroll
                  for (int m = 0; m < 4; ++m) {
                      const f32x4 pr = m == 0 ? p0 : acc[ai][0][m > 0 ? m - 1 : 0][n], nx = m == 3 ? n3 : acc[ai][0][m < 3 ? m + 1 : 3][n];
                      const f32x4 gg = pr * w0 + acc[ai][0][m][n] * w1 + nx * w2 + bb;
#pragma unroll
                      for (int j = 0; j < 4; ++j) sg[m][j] = gg[j] * __builtin_amdgcn_rcpf(1.0f + __builtin_amdgcn_exp2f(gg[j] * -1.4426950408889634f));
                  } }
                __builtin_amdgcn_sched_barrier(0);
                { const f32x4 w0 = *(const PG8_LAS f32x4*)(wl + 128), w1 = *(const PG8_LAS f32x4*)(wl + 256 + 128), w2 = *(const PG8_LAS f32x4*)(wl + 512 + 128), bb = *(const PG8_LAS f32x4*)(wl + 768 + 128);
                  f32x4 hu = {0.f, 0.f, 0.f, 0.f}, hd = hu;
                  if (has_up) hu = *(const PG8_LAS f32x4*)(pu + 8);
                  if (has_dn) hd = *(const PG8_LAS f32x4*)(pd + 8);
                  f32x4 p0, n3;
#pragma unroll
                  for (int j = 0; j < 4; ++j) { const float t = dpp_ror<0x121>(acc[ai][1][3][n][j]), d = dpp_ror<0x12F>(acc[ai][1][0][n][j]); p0[j] = fr == 0 ? hu[j] : t; n3[j] = fr == 15 ? hd[j] : d; }
#pragma unroll
                  for (int m = 0; m < 4; ++m) {
                      asm volatile("" ::: "memory");
                      const f32x4 pr = m == 0 ? p0 : acc[ai][1][m > 0 ? m - 1 : 0][n], nx = m == 3 ? n3 : acc[ai][1][m < 3 ? m + 1 : 3][n];
                      const f32x4 o = (pr * w0 + acc[ai][1][m][n] * w1 + nx * w2 + bb) * sg[m];
                      const int trow = ai * HALF + wr * 64 + fr * 4 + m;
                      u32x2 w; w.x = cvt_pk_bf16(o[0], o[1]); w.y = cvt_pk_bf16(o[2], o[3]);
                      if (n == 0) keep[ai][m] = w;
                      else if (trow != 0 && trow != 255) { u32x4 w4; w4.x = keep[ai][m].x; w4.y = keep[ai][m].y; w4.z = w.x; w4.w = w.y;
                          *(u32x4*)(G + (size_t)(u.pm * BM + trow) * 5632 + gcol) = w4; }
                  } }
            }
        }
    }
};
template <class Epi, class Sched, bool ALIGN_EPI = false, bool SP2 = false>
__device__ __forceinline__ void gemm_phase(PG8_LAS unsigned char* lds, const Gemm g, const Sched& S, const Epi& E, const int wave0) {
    const int tid_ = wave0 * 64 + fresh_lane();
    const int tid = tid_, wid = __builtin_amdgcn_readfirstlane(tid >> 6), lane = tid & 63, wr = wid >> 2, wc = wid & 3, fr = lane & 15, fq = lane >> 4;
    const int K = g.ld, nt = g.K / BK;
    unsigned voffA[2], voffB[2];
#pragma unroll
    for (int i = 0; i < 2; ++i) { int R, C; stage_rc(tid * 16 + i * 8192, R, C); const int Rb = Epi::PERM ? ((R & ~31) + perm32(R & 31)) : R;
        const int Ra = Epi::PERMA ? ((R & ~63) + (R & 15) * 4 + ((R >> 4) & 3)) : R;
        voffA[i] = (unsigned)(Ra * K + C) * 2u; voffB[i] = (unsigned)(Rb * K + C) * 2u; }
    const size_t kstep = (size_t)(BK * 2);
    const size_t hstep = (size_t)HALF * K * 2;
    const size_t tstep = 2 * hstep;
    const unsigned ldsw = (unsigned)wid * 1024u;
    const int aoff = lds_byte(wr * 64 + fr, fq * 8), boff = lds_byte(wc * 32 + fr, fq * 8);
#define PG8_SA(b, h) (((b) * 2 + (h)) * HTB)
#define PG8_SB(b, h) ((4 + (b) * 2 + (h)) * HTB)
#define PG8_STAGE(bufoff, gbase, voff) do { _Pragma("unroll") for (int _i = 0; _i < 2; ++_i) \
        __builtin_amdgcn_global_load_lds((const unsigned*)((const char*)(gbase) + (voff)[_i]), (PG8_LAS unsigned*)(lds + (bufoff) + ldsw + _i * 8192), 16, 0, 0); } while (0)
#define PG8_LDA(dst, b, h) do { _Pragma("unroll") for (int m = 0; m < 4; ++m) _Pragma("unroll") for (int k = 0; k < 2; ++k) dst[m][k] = *(const PG8_LAS bf16x8*)(lds + PG8_SA(b, h) + aoff + m * 2048 + k * 1024); } while (0)
#define PG8_LDB(dst, b, h) do { _Pragma("unroll") for (int n = 0; n < 2; ++n) _Pragma("unroll") for (int k = 0; k < 2; ++k) dst[n][k] = *(const PG8_LAS bf16x8*)(lds + PG8_SB(b, h) + boff + n * 2048 + k * 1024); } while (0)
#define PG8_MMA(ai, bj, At, Bt) do { __builtin_amdgcn_s_setprio(1); _Pragma("unroll") for (int m = 0; m < 4; ++m) _Pragma("unroll") for (int n = 0; n < 2; ++n) _Pragma("unroll") for (int k = 0; k < 2; ++k) \
        acc[ai][bj][m][n] = __builtin_amdgcn_mfma_f32_16x16x32_bf16(Bt[n][k], At[m][k], acc[ai][bj][m][n], 0, 0, 0); __builtin_amdgcn_s_setprio(0); } while (0)
#define PG8_WAIT_V(n) asm volatile("s_waitcnt vmcnt(" #n ")" ::: "memory")
#define PG8_WAIT_L(n) asm volatile("s_waitcnt lgkmcnt(" #n ")" ::: "memory")
#define PG8_BAR __builtin_amdgcn_s_barrier()
#define PG8_SCHED __builtin_amdgcn_sched_barrier(0)
    Unit cur, nxt; int ui = 0;
    if (!S.next(0, cur)) return;
    f32x4 acc[2][2][4][2];
#pragma unroll
    for (int a = 0; a < 2; ++a)
#pragma unroll
        for (int b = 0; b < 2; ++b)
#pragma unroll
            for (int m = 0; m < 4; ++m)
#pragma unroll
                for (int n = 0; n < 2; ++n) acc[a][b][m][n] = (f32x4){0.f, 0.f, 0.f, 0.f};
    bf16x8 At[4][2], B0[2][2], B1[2][2];
    const char* cA = (const char*)g.A + (size_t)cur.pm * tstep + (size_t)cur.pk * g.K * 2; const char* cB = (const char*)g.Bt + (size_t)cur.pn * tstep + (size_t)cur.pk * g.K * 2;
    S.a_ready(cur);
    if constexpr (SP2) {
        PG8_STAGE(PG8_SB(0, 0), cB, voffB); PG8_STAGE(PG8_SB(0, 1), cB + hstep, voffB); PG8_STAGE(PG8_SA(0, 0), cA, voffA); PG8_STAGE(PG8_SA(0, 1), cA + hstep, voffA);
        if (wr == 1) PG8_BAR;
        PG8_WAIT_V(2); PG8_BAR;
        PG8_STAGE(PG8_SB(1, 0), cB + kstep, voffB); PG8_STAGE(PG8_SA(1, 0), cA + kstep, voffA); PG8_STAGE(PG8_SB(1, 1), cB + hstep + kstep, voffB);
        PG8_WAIT_V(6); PG8_BAR;
    } else {
        PG8_STAGE(PG8_SB(0, 0), cB, voffB); PG8_STAGE(PG8_SA(0, 0), cA, voffA); PG8_STAGE(PG8_SB(0, 1), cB + hstep, voffB); PG8_STAGE(PG8_SA(0, 1), cA + hstep, voffA);
        if (wr == 1) PG8_BAR;
        PG8_WAIT_V(4); PG8_BAR;
        PG8_STAGE(PG8_SB(1, 0), cB + kstep, voffB); PG8_STAGE(PG8_SA(1, 0), cA + kstep, voffA); PG8_STAGE(PG8_SB(1, 1), cB + hstep + kstep, voffB);
        PG8_WAIT_V(6); PG8_BAR;
    }
    for (;;) {
        const bool has_next = S.next(ui + 1, nxt);
        const char* nA = has_next ? (const char*)g.A + (size_t)nxt.pm * tstep + (size_t)nxt.pk * g.K * 2 : cA; const char* nB = has_next ? (const char*)g.Bt + (size_t)nxt.pn * tstep + (size_t)nxt.pk * g.K * 2 : cB;
        for (int t = 0; t < nt; t += 2) {
            const bool last = (t == nt - 2);
            const char* a1 = cA + (size_t)(t + 1) * kstep;
            const char* a2 = last ? nA : cA + (size_t)(t + 2) * kstep; const char* b2 = last ? nB : cB + (size_t)(t + 2) * kstep;
            const char* a3 = a2 + kstep; const char* b3 = b2 + kstep;
            if (last && has_next) S.a_ready(nxt);
            if constexpr (SP2) {
            PG8_LDB(B0, 0, 0); PG8_LDB(B1, 0, 1); PG8_SCHED; PG8_LDA(At, 0, 0); PG8_STAGE(PG8_SA(1, 1), a1 + hstep, voffA);
            PG8_WAIT_V(8); PG8_WAIT_L(0); PG8_BAR; PG8_MMA(0, 0, At, B0); PG8_MMA(0, 1, At, B1); PG8_BAR; PG8_SCHED;
            PG8_LDA(At, 0, 1); PG8_STAGE(PG8_SB(0, 0), b2, voffB); PG8_STAGE(PG8_SB(0, 1), b2 + hstep, voffB); PG8_STAGE(PG8_SA(0, 0), a2, voffA);
            PG8_WAIT_V(8); PG8_WAIT_L(0); PG8_BAR; PG8_MMA(1, 0, At, B0); PG8_MMA(1, 1, At, B1); PG8_BAR; PG8_SCHED;
            PG8_LDB(B0, 1, 0); PG8_LDB(B1, 1, 1); PG8_SCHED; PG8_LDA(At, 1, 0); PG8_STAGE(PG8_SA(0, 1), a2 + hstep, voffA);
            PG8_WAIT_V(8); PG8_WAIT_L(0); PG8_BAR; PG8_MMA(0, 0, At, B0); PG8_MMA(0, 1, At, B1); PG8_BAR; PG8_SCHED;
            PG8_LDA(At, 1, 1); PG8_STAGE(PG8_SB(1, 0), b3, voffB); PG8_STAGE(PG8_SB(1, 1), b3 + hstep, voffB); PG8_STAGE(PG8_SA(1, 0), a3, voffA);
            PG8_WAIT_V(8); PG8_WAIT_L(0); PG8_BAR; PG8_MMA(1, 0, At, B0); PG8_MMA(1, 1, At, B1); PG8_BAR; PG8_SCHED;
            } else {
            PG8_LDB(B0, 0, 0); PG8_SCHED; PG8_LDA(At, 0, 0); PG8_STAGE(PG8_SA(1, 1), a1 + hstep, voffA);
            PG8_WAIT_L(8); PG8_BAR; PG8_WAIT_L(0); PG8_MMA(0, 0, At, B0); PG8_BAR; PG8_SCHED;
            PG8_LDB(B1, 0, 1); PG8_STAGE(PG8_SB(0, 0), b2, voffB);
            PG8_BAR; PG8_WAIT_L(0); PG8_MMA(0, 1, At, B1); PG8_BAR;
            PG8_LDA(At, 0, 1); PG8_STAGE(PG8_SA(0, 0), a2, voffA);
            PG8_BAR; PG8_WAIT_L(0); PG8_MMA(1, 0, At, B0); PG8_BAR; PG8_SCHED;
            PG8_STAGE(PG8_SB(0, 1), b2 + hstep, voffB);
            PG8_WAIT_V(6); PG8_BAR; PG8_MMA(1, 1, At, B1); PG8_BAR;
            PG8_LDB(B0, 1, 0); PG8_SCHED; PG8_LDA(At, 1, 0); PG8_STAGE(PG8_SA(0, 1), a2 + hstep, voffA);
            PG8_WAIT_L(8); PG8_BAR; PG8_WAIT_L(0); PG8_MMA(0, 0, At, B0); PG8_BAR; PG8_SCHED;
            PG8_LDB(B1, 1, 1); PG8_STAGE(PG8_SB(1, 0), b3, voffB);
            PG8_BAR; PG8_WAIT_L(0); PG8_MMA(0, 1, At, B1); PG8_BAR;
            PG8_LDA(At, 1, 1); PG8_STAGE(PG8_SA(1, 0), a3, voffA);
            PG8_BAR; PG8_WAIT_L(0); PG8_MMA(1, 0, At, B0); PG8_BAR; PG8_SCHED;
            PG8_STAGE(PG8_SB(1, 1), b3 + hstep, voffB);
            PG8_WAIT_V(6); PG8_BAR; PG8_MMA(1, 1, At, B1); PG8_BAR;
            }
        }
        if constexpr (ALIGN_EPI) { if (wr == 0) PG8_BAR; }
        if constexpr (!Epi::AFTER_DRAIN) { E(acc, cur, wr, wc, fr, fq); S.done(cur); }
        if (!has_next) break;
#pragma unroll
        for (int a = 0; a < 2; ++a)
#pragma unroll
            for (int b = 0; b < 2; ++b)
#pragma unroll
                for (int m = 0; m < 4; ++m)
#pragma unroll
                    for (int n = 0; n < 2; ++n) acc[a][b][m][n] = (f32x4){0.f, 0.f, 0.f, 0.f};
        cur = nxt; cA = nA; cB = nB; ++ui;
        if constexpr (ALIGN_EPI) { if (wr == 1) PG8_BAR; }
    }
    PG8_WAIT_V(0);
    if constexpr (!ALIGN_EPI) { if (wr == 0) PG8_BAR; }
    PG8_BAR;
    if constexpr (Epi::AFTER_DRAIN) { E.fused(acc, cur, wr, wc, fr, fq, lds, wid, lane); S.done(cur); }
#undef PG8_SA
#undef PG8_SB
#undef PG8_STAGE
#undef PG8_LDA
#undef PG8_LDB
#undef PG8_MMA
#undef PG8_WAIT_V
#undef PG8_WAIT_L
#undef PG8_BAR
#undef PG8_SCHED
}
}
#define XB_TMO      128
#define XB_XCNT(j)  (256  + 64 * (j))
#define XB_XSUB(j)  (1280 + 64 * (j))
#define XB_XGEN(j)  (2304 + 64 * (j))
#define XB_TOP      3328
#define XB_TOPGEN   3392
#define XCD_BAR_WORDS 3456
#define XB_SPIN_CAP (1u << 18)

__device__ __forceinline__ unsigned xb_ld(unsigned* p)              { return __hip_atomic_load(p, __ATOMIC_RELAXED, __HIP_MEMORY_SCOPE_AGENT); }
__device__ __forceinline__ unsigned xb_add(unsigned* p, unsigned v) { return __hip_atomic_fetch_add(p, v, __ATOMIC_RELAXED, __HIP_MEMORY_SCOPE_AGENT); }
__device__ __forceinline__ unsigned xb_xcc_id() { return (unsigned)__builtin_amdgcn_s_getreg((3 << 11) | 20) & 0xFu; }
#define XB_SPIN(cond, bar) do { unsigned _sp = 0; while (cond) { __builtin_amdgcn_s_sleep(1); \
    if ((++_sp & 255u) == 0u) { if (xb_ld(&(bar)[XB_TMO])) break; if (_sp > XB_SPIN_CAP) { atomicAdd(&(bar)[XB_TMO], 1u); break; } } } } while (0)

struct XcdBarrier {
    unsigned* bar; unsigned x; int w0;
    volatile LAS unsigned* st;
};

__device__ __forceinline__ XcdBarrier xcd_barrier_post(unsigned* bar, volatile LAS unsigned* st, int w0) {
    XcdBarrier b; b.bar = bar; b.x = xb_xcc_id(); b.st = st; b.w0 = w0;
    if (w0 == 0 && fresh_lane() == 0) (void)xb_add(&bar[XB_XCNT(b.x)], 1u);
    return b;
}
__device__ __forceinline__ void xcd_barrier_complete(unsigned* bar, unsigned x, unsigned& nloc, unsigned& nx) {
    const unsigned G = gridDim.x * gridDim.y * gridDim.z;
    unsigned sum, cnt, mine, sp = 0u;
    for (;;) {
        sum = 0u; cnt = 0u; mine = 0u;
#pragma unroll
        for (unsigned j = 0; j < 16; ++j) { const unsigned c = xb_ld(&bar[XB_XCNT(j)]); sum += c; cnt += (c > 0u) ? 1u : 0u; mine = (j == x) ? c : mine; }
        if (sum == G) break;
        __builtin_amdgcn_s_sleep(1);
        if ((++sp & 255u) == 0u) { if (xb_ld(&bar[XB_TMO])) break; if (sp > XB_SPIN_CAP) { atomicAdd(&bar[XB_TMO], 1u); break; } }
    }
    nloc = mine > 0u ? mine : 1u; nx = cnt > 0u ? cnt : 1u;
}

__device__ __forceinline__ void xcd_barrier(const XcdBarrier& b) {
    asm volatile("s_waitcnt vmcnt(0)" ::: "memory");
    __syncthreads();
    if (b.w0 == 0 && fresh_lane() == 0) {
        unsigned* bar = b.bar;
        __builtin_amdgcn_s_waitcnt(0);
        unsigned nloc = b.st[0], nx = b.st[1];
        if (nloc == 0u) { xcd_barrier_complete(bar, b.x, nloc, nx); b.st[0] = nloc; b.st[1] = nx; }
        const unsigned old = xb_add(&bar[XB_XSUB(b.x)], 1u);
        const unsigned gen = old / nloc;
        if (old + 1u == (gen + 1u) * nloc) {
            __builtin_amdgcn_fence(__ATOMIC_RELEASE, "agent");
            asm volatile("s_waitcnt vmcnt(0)" ::: "memory");
            const unsigned og = xb_add(&bar[XB_TOP], 1u);
            const unsigned tg = og / nx;
            if (og + 1u == (tg + 1u) * nx) xb_add(&bar[XB_TOPGEN], 1u);
            else XB_SPIN(xb_ld(&bar[XB_TOPGEN]) == tg, bar);
            __builtin_amdgcn_fence(__ATOMIC_ACQUIRE, "agent");
            xb_add(&bar[XB_XGEN(b.x)], 1u);
            asm volatile("s_waitcnt vmcnt(0)" ::: "memory");
        } else {
            XB_SPIN(xb_ld(&bar[XB_XGEN(b.x)]) == gen, bar);
            __builtin_amdgcn_fence(__ATOMIC_ACQUIRE, "agent");
            asm volatile("s_waitcnt vmcnt(0)" ::: "memory");
        }
    }
    __syncthreads();
}
constexpr int DM = 2048, NBATCH = 2, SEQ = 4096, DEPTH = 4, CTXL = 256;
constexpr int NLAT = NBATCH * SEQ, NCTX = NBATCH * CTXL, NROW = NLAT + NCTX;
constexpr int NKEY = SEQ + CTXL;
constexpr int INC = 3648, INP = 3840;
constexpr int FF = 5632, FF2 = 2 * FF;
constexpr int C_CQ = 0, C_CKV = 512, C_KR = 768, C_POOL = 832, C_SQ = 1344, C_SK = 1856, C_SV = 1984, C_NQ = 2112, C_NK = 2624, C_NV = 3136;
constexpr float EPS = 1e-6f;
constexpr float LOG2E = 1.4426950408889634f;
constexpr int NWAVES = 8, NTHREADS = 512;
enum { I_X = 0, I_C, I_CTX, I_CCTX, I_WMOD, I_BMOD, I_GMIX, I_GFFN, I_WIN, I_WOUT, I_QAN, I_WQB, I_KVAN, I_WKVB, I_QNN, I_QRN, I_KNN, I_KRN,
       I_POOLW, I_POOLS, I_SQN, I_SKN, I_SINK, I_NQN, I_NKN, I_RPB, I_WUP, I_CONVW, I_CONVB, I_WDN, N_IN };

constexpr size_t MiB = 1u << 20;
constexpr size_t WS_CTL = 0, CTL_ZERO_BYTES = 64 * 1024;
constexpr size_t WS_MOD = 1 * MiB;
constexpr size_t WS_ROPE = WS_MOD + 640 * 1024;
constexpr size_t WS_WIN = 2 * MiB;
constexpr size_t WS_WOUT = 62 * MiB;
constexpr size_t WS_WUP = 94 * MiB;
constexpr size_t WS_WDN = 270 * MiB;
constexpr size_t WS_WQB = 358 * MiB;
constexpr size_t WS_WKVB = 361 * MiB;
constexpr size_t WS_WPOOL = 363 * MiB;
constexpr size_t WS_X = 365 * MiB;
constexpr size_t WS_H = 433 * MiB;
constexpr size_t WS_P = 467 * MiB;
constexpr size_t WS_MIX = 531 * MiB;
constexpr size_t WS_QN = 565 * MiB;
constexpr size_t WS_KVN = 574 * MiB;
constexpr size_t WS_POOLD = 579 * MiB;
constexpr size_t WS_WOP = WS_POOLD;
constexpr size_t WS_QRAW = 588 * MiB;
constexpr size_t WS_KVRAW = 601 * MiB;
constexpr size_t WS_QMLA = 618 * MiB;
constexpr size_t WS_KMLA = 631 * MiB;
constexpr size_t WS_VTMLA = 644 * MiB;
constexpr size_t WS_QSWA = 653 * MiB;
constexpr size_t WS_KSWA = 662 * MiB;
constexpr size_t WS_VTSWA = 665 * MiB;
constexpr size_t WS_QNA = 668 * MiB;
constexpr size_t WS_KNA = 677 * MiB;
constexpr size_t WS_VTNA = 686 * MiB;
constexpr size_t WS_AUP = 695 * MiB;
constexpr size_t WS_RAW = 823 * MiB;
constexpr size_t WS_G = 882 * MiB;
constexpr size_t WS_SLAB = 976 * MiB;
constexpr size_t WS_END = 1024 * MiB;
constexpr int CW_BAR = 1024;
constexpr int CW_PANEL = 10240;
constexpr int CW_PAIR = 8192;

constexpr int RING_OFF = 0, RING_BYTES = 131072;
constexpr int LDSCTL_OFF = RING_BYTES, MISC_OFF = LDSCTL_OFF + 320;
constexpr int XB_OFF = LDSCTL_OFF + 1024;
constexpr int LDS_BYTES = 147456;

struct Args { const float* in[N_IN]; float* out; unsigned char* ws; int ph_lo, ph_hi; };
struct Frame {
    LAS unsigned char* lds;
    int tid, lane, wave, gw, ngw;
};
constexpr int PTAB_OFF = LDS_BYTES - 512;
DI const float* inp(const Frame& F, int i) {
    const v2u w = *(const LAS v2u*)(F.lds + PTAB_OFF + 8 * i);
    const unsigned lo = __builtin_amdgcn_readfirstlane(w.x), hi = __builtin_amdgcn_readfirstlane(w.y);
    return (const float*)(const GAS float*)(((unsigned long long)hi << 32) | lo);
}
template <int CTRL> DI float dppf(float x) { return __builtin_bit_cast(float, __builtin_amdgcn_update_dpp(0, __builtin_bit_cast(int, x), CTRL, 0xf, 0xf, false)); }
DI float bperm(float x, int src_lane) { return __builtin_bit_cast(float, __builtin_amdgcn_ds_bpermute(src_lane << 2, __builtin_bit_cast(int, x))); }
DI float sum4(float v) { v += dppf<0xB1>(v); v += dppf<0x4E>(v); return v; }
DI float sum8(float v) { v = sum4(v); v += dppf<0x141>(v); return v; }
DI float sum16(float v) { v = sum8(v); v += dppf<0x140>(v); return v; }
DI float wave_sum(float v) {
    v = sum16(v);
    return (__builtin_amdgcn_readlane(v, 0) + __builtin_amdgcn_readlane(v, 16)) + (__builtin_amdgcn_readlane(v, 32) + __builtin_amdgcn_readlane(v, 48));
}
DI float silu_f(float x) { return x / (1.f + __expf(-x)); }
DI void unpack8(const bf16x8 v, float (&f)[8]) {
    const v4u w = __builtin_bit_cast(v4u, v);
    f[0] = bflo(w.x); f[1] = bfhi(w.x); f[2] = bflo(w.y); f[3] = bfhi(w.y); f[4] = bflo(w.z); f[5] = bfhi(w.z); f[6] = bflo(w.w); f[7] = bfhi(w.w);
}
DI v4u pack8(const float (&f)[8]) { v4u w; w.x = pk2(f[0], f[1]); w.y = pk2(f[2], f[3]); w.z = pk2(f[4], f[5]); w.w = pk2(f[6], f[7]); return w; }

DI void p0_transpose_item(const float* W, int K, int N, bf16* WT, LAS float* scr, int item, int lane, bool perm_up = false, bool perm_q = false) {
    const int nblk = N / 32, kb = item / nblk, nb = item % nblk, k0 = 64 * kb, n0 = 32 * nb;
#pragma unroll 8
    for (int i = 0; i < 32; ++i) { const int kk = 2 * i + (lane >> 5); scr[kk * 33 + (lane & 31)] = W[(size_t)(k0 + kk) * N + n0 + (lane & 31)]; }
    LDS_WAIT(); asm volatile("" ::: "memory");
    const int c = lane & 7;
#pragma unroll
    for (int j = 0; j < 4; ++j) { const int n = (lane >> 3) + 8 * j; const LAS float* s = scr + (8 * c) * 33 + n;
        v4u o; o.x = pk2(s[0 * 33], s[1 * 33]); o.y = pk2(s[2 * 33], s[3 * 33]); o.z = pk2(s[4 * 33], s[5 * 33]); o.w = pk2(s[6 * 33], s[7 * 33]);
        const int nn = n0 + n; int nrow = perm_up ? ((nn % FF) / 128) * 256 + (nn / FF) * 128 + (nn % 128) : nn;
        if (perm_q) { const int hh = nn / 192, wi = nn % 192;
            if (wi < 128) nrow = hh * 128 + wi;
            else { const int d = wi - 128, sg = d >> 5, i = d & 31, ii = i & 15; nrow = 512 + hh * 64 + sg * 32 + 8 * (ii >> 2) + 4 * (i >> 4) + (ii & 3); } }
        *(v4u*)(WT + (size_t)nrow * K + k0 + 8 * c) = o; }
    LDS_WAIT(); asm volatile("" ::: "memory");
}
#ifndef P0_ABL
#define P0_ABL 0
#endif
DI void p0_prologue(const Args& a, Frame& F, int rep = 0) {
    const bool skipT = rep > 0 && (P0_ABL & 1), skipM = rep > 0 && (P0_ABL & 2);
    unsigned char* ws = a.ws;
    LAS float* scr = (LAS float*)(F.lds + RING_OFF + F.wave * 16384);
    constexpr int IT_IN = (DM / 64) * (INC / 32), IT_OUT = (DM / 64) * (DM / 32), IT_UP = (DM / 64) * (FF2 / 32), IT_DN = (FF / 64) * (DM / 32), IT_QB = (512 / 64) * (768 / 32), IT_KVB = (256 / 64) * (1024 / 32);
    constexpr int IT_L = IT_IN + IT_OUT + IT_UP + IT_DN + IT_QB + IT_KVB;
    for (int it = F.gw; it < (skipT ? 0 : DEPTH * IT_L); it += F.ngw) {
        const int l = it / IT_L; int r = it % IT_L;
        if (r < IT_IN) { p0_transpose_item(inp(F, I_WIN) + (size_t)l * DM * INC, DM, INC, (bf16*)(ws + WS_WIN) + (size_t)l * INP * DM, scr, r, F.lane); continue; } r -= IT_IN;
        if (r < IT_OUT) { const int kb = r / (DM / 32);
            if (kb >= 8 && kb < 16) p0_transpose_item(inp(F, I_WOUT) + (size_t)l * DM * DM + (size_t)512 * DM, 512, DM, (bf16*)(ws + WS_WOP) + (size_t)l * DM * 512, scr, r - 8 * (DM / 32), F.lane);
            else p0_transpose_item(inp(F, I_WOUT) + (size_t)l * DM * DM, DM, DM, (bf16*)(ws + WS_WOUT) + (size_t)l * DM * DM, scr, r, F.lane);
            continue; } r -= IT_OUT;
        if (r < IT_UP) { p0_transpose_item(inp(F, I_WUP) + (size_t)l * DM * FF2, DM, FF2, (bf16*)(ws + WS_WUP) + (size_t)l * FF2 * DM, scr, r, F.lane, true); continue; } r -= IT_UP;
        if (r < IT_DN) { p0_transpose_item(inp(F, I_WDN) + (size_t)l * FF * DM, FF, DM, (bf16*)(ws + WS_WDN) + (size_t)l * DM * FF, scr, r, F.lane); continue; } r -= IT_DN;
        if (r < IT_QB) { p0_transpose_item(inp(F, I_WQB) + (size_t)l * 512 * 768, 512, 768, (bf16*)(ws + WS_WQB) + (size_t)l * 768 * 512, scr, r, F.lane, false, true); continue; } r -= IT_QB;
        p0_transpose_item(inp(F, I_WKVB) + (size_t)l * 256 * 1024, 256, 1024, (bf16*)(ws + WS_WKVB) + (size_t)l * 1024 * 256, scr, r, F.lane);
    }
    const int gt = F.gw * 64 + F.lane, ngt = F.ngw * 64;
    for (int i = gt; i < DEPTH * (INP - INC) * (DM / 8); i += ngt) { const int l = i / ((INP - INC) * (DM / 8)), r = i % ((INP - INC) * (DM / 8));
        *(v4u*)((bf16*)(ws + WS_WIN) + (size_t)l * INP * DM + (size_t)INC * DM + (size_t)r * 8) = (v4u){0u, 0u, 0u, 0u}; }
    for (int i = gt; i < DEPTH * 512 * 64; i += ngt) { const int l = i / (512 * 64), r = i % (512 * 64), k = r / 64, d0 = (r % 64) * 8; const int g = k >> 7, c = k & 127, g2 = d0 >> 7, dd = d0 & 127;
        v4u o = (v4u){0u, 0u, 0u, 0u};
        if (g == g2) { const float* s = inp(F, I_POOLW) + (((size_t)l * 4 + g) * 128 + c) * 128 + dd; const float* sc = inp(F, I_POOLS) + (size_t)l * 512 + g * 128 + dd;
            o.x = pk2(s[0] * sc[0], s[1] * sc[1]); o.y = pk2(s[2] * sc[2], s[3] * sc[3]); o.z = pk2(s[4] * sc[4], s[5] * sc[5]); o.w = pk2(s[6] * sc[6], s[7] * sc[7]); }
        *(v4u*)((bf16*)(ws + WS_WPOOL) + (size_t)l * 512 * 512 + (size_t)k * 512 + d0) = o; }
    for (int i = gt; i < 1024; i += ngt) { const int pos = i >> 4, fi = i & 15; const float inv = powf(10000.0f, -(float)(2 * fi) / 32.0f); const float ang = (float)pos * inv;
        ((f32x2*)(ws + WS_ROPE))[i] = (f32x2){cosf(ang), sinf(ang)}; }
    __syncthreads();
    LAS float* sl = (LAS float*)(F.lds + RING_OFF);
    LAS float* red = (LAS float*)(F.lds + RING_OFF + 24576);
    if (!skipM) for (int i = F.tid; i < 3 * DM; i += NTHREADS) { const int r = i / DM, k = i % DM; sl[i] = silu_f(r < 2 ? inp(F, I_C)[r * DM + k] : inp(F, I_CCTX)[k]); }
    __syncthreads();
    for (int u = blockIdx.x; u < (skipM ? 0 : DEPTH * 64); u += gridDim.x) {
        const int l = u >> 6, n0 = (u & 63) * 192;
        const float* W = inp(F, I_WMOD) + (size_t)l * DM * 12288 + n0 + F.lane * 3;
        float acc[3][3];
#pragma unroll
        for (int r = 0; r < 3; ++r)
#pragma unroll
            for (int j = 0; j < 3; ++j) acc[r][j] = 0.f;
        const int kb = F.wave * 256;
#pragma unroll 16
        for (int k = kb; k < kb + 256; ++k) { const float* wp = W + (size_t)k * 12288; const float w0 = wp[0], w1 = wp[1], w2 = wp[2];
            const float s0 = sl[k], s1 = sl[DM + k], s2 = sl[2 * DM + k];
            acc[0][0] += s0 * w0; acc[0][1] += s0 * w1; acc[0][2] += s0 * w2; acc[1][0] += s1 * w0; acc[1][1] += s1 * w1; acc[1][2] += s1 * w2; acc[2][0] += s2 * w0; acc[2][1] += s2 * w1; acc[2][2] += s2 * w2; }
#pragma unroll
        for (int r = 0; r < 3; ++r)
#pragma unroll
            for (int j = 0; j < 3; ++j) red[(F.wave * 9 + r * 3 + j) * 64 + F.lane] = acc[r][j];
        __syncthreads();
        for (int o = F.tid; o < 3 * 192; o += NTHREADS) { const int r = o / 192, c = o % 192, ln = c / 3, j = c % 3; float sum = inp(F, I_BMOD)[(size_t)l * 12288 + n0 + c];
#pragma unroll
            for (int w = 0; w < 8; ++w) sum += red[(w * 9 + r * 3 + j) * 64 + ln];
            ((float*)(ws + WS_MOD))[((size_t)l * 3 + r) * 12288 + n0 + c] = sum; }
        __syncthreads();
    }
}

DI void norm_phase(Frame& F, const float* xlat, const float* xctx, const float* g, const float* modl, int ch_shift, int ch_scale, bf16* H, int nrows,
                   const float* slab, int nsplit, const float* cgate, float* xctx_out, bool lat = true) {
    int wrows = nrows;
    if (nsplit > 0) {
        wrows = NLAT;
        LAS float* red = (LAS float*)(F.lds + RING_OFF);
        const float* sh = modl + (size_t)2 * 12288 + ch_shift * DM; const float* sc = modl + (size_t)2 * 12288 + ch_scale * DM;
        const int hf = F.wave >> 2, c = (F.wave & 3) * 512 + 8 * F.lane;
        for (int cr0 = 2 * blockIdx.x; cr0 < NCTX; cr0 += 2 * gridDim.x) { const int cr = cr0 + hf;
            f32x4 v[2], acc[2], gt[2], gg[2], s1[2], s0[2];
#pragma unroll
            for (int k = 0; k < 2; ++k) { const int ck = c + 4 * k; const float* sp = slab + (size_t)cr * DM + ck;
                v[k] = *(const f32x4*)(xctx + (size_t)cr * DM + ck);
                f32x4 pa[11];
#pragma unroll
                for (int s2 = 0; s2 < 8; ++s2) pa[s2] = *(const f32x4*)(sp + (size_t)s2 * NCTX * DM);
#pragma unroll
                for (int s2 = 8; s2 < 11; ++s2) pa[s2] = nsplit > 8 ? *(const f32x4*)(sp + (size_t)s2 * NCTX * DM) : (f32x4){0.f, 0.f, 0.f, 0.f};
                gt[k] = *(const f32x4*)(cgate + ck); gg[k] = *(const f32x4*)(g + ck); s1[k] = *(const f32x4*)(sc + ck); s0[k] = *(const f32x4*)(sh + ck);
                acc[k] = ((pa[0] + pa[1]) + (pa[2] + pa[3])) + ((pa[4] + pa[5]) + (pa[6] + pa[7])) + ((pa[8] + pa[9]) + pa[10]); }
            float sq = 0.f;
#pragma unroll
            for (int k = 0; k < 2; ++k) { v[k] += gt[k] * acc[k]; *(f32x4*)(xctx_out + (size_t)cr * DM + c + 4 * k) = v[k];
                sq += (v[k].x * v[k].x + v[k].y * v[k].y) + (v[k].z * v[k].z + v[k].w * v[k].w); }
            const float ssw = wave_sum(sq);
            if (F.lane == 0) red[F.wave] = ssw;
            __syncthreads();
            const float ss = (red[hf * 4] + red[hf * 4 + 1]) + (red[hf * 4 + 2] + red[hf * 4 + 3]);
            const float rstd = __builtin_amdgcn_rsqf(ss * (1.0f / DM) + EPS);
            const f32x4 y0 = (v[0] * rstd * gg[0]) * (s1[0] + 1.0f) + s0[0], y1 = (v[1] * rstd * gg[1]) * (s1[1] + 1.0f) + s0[1];
            v4u o; o.x = pk2(y0.x, y0.y); o.y = pk2(y0.z, y0.w); o.z = pk2(y1.x, y1.y); o.w = pk2(y1.z, y1.w); *(v4u*)(H + (size_t)(NLAT + cr) * DM + c) = o;
            __syncthreads();
        }
    }
    if (!lat) wrows = 0;
    for (int r4 = F.gw * 4; r4 < wrows; r4 += F.ngw * 4) {
        const int bid = r4 < SEQ ? 0 : (r4 < NLAT ? 1 : 2);
        const float* sh = modl + (size_t)bid * 12288 + ch_shift * DM; const float* sc = modl + (size_t)bid * 12288 + ch_scale * DM;
        f32x4 ga[8], sb[8];
#pragma unroll
        for (int j = 0; j < 8; ++j) { const int c = 256 * j + 4 * F.lane; ga[j] = *(const f32x4*)(g + c) * (*(const f32x4*)(sc + c) + 1.0f); sb[j] = *(const f32x4*)(sh + c); }
        const float* src0 = r4 < NLAT ? xlat + (size_t)r4 * DM : xctx + (size_t)(r4 - NLAT) * DM;
        f32x4 v[8], nx[8];
#pragma unroll
        for (int j = 0; j < 8; ++j) v[j] = *(const f32x4*)(src0 + 256 * j + 4 * F.lane);
#pragma unroll
        for (int rr = 0; rr < 4; ++rr) {
            if (rr < 3) {
#pragma unroll
                for (int j = 0; j < 8; ++j) nx[j] = *(const f32x4*)(src0 + (size_t)(rr + 1) * DM + 256 * j + 4 * F.lane); }
            float ss = 0.f;
#pragma unroll
            for (int j = 0; j < 8; ++j) ss += (v[j].x * v[j].x + v[j].y * v[j].y) + (v[j].z * v[j].z + v[j].w * v[j].w);
            const float rstd = __builtin_amdgcn_rsqf(wave_sum(ss) * (1.0f / DM) + EPS);
#pragma unroll
            for (int j = 0; j < 8; ++j) { const f32x4 y = (v[j] * rstd) * ga[j] + sb[j];
                v2u o; o.x = pk2(y.x, y.y); o.y = pk2(y.z, y.w); *(v2u*)(H + (size_t)(r4 + rr) * DM + 256 * j + 4 * F.lane) = o; }
#pragma unroll
            for (int j = 0; j < 8; ++j) v[j] = nx[j];
        }
    }
}


DI int pi32(int r) { return (r & ~12) | ((r & 4) << 1) | ((r & 8) >> 1); }
DI size_t kimg_off(int kidx, int c) { return (size_t)(kidx >> 5) * 12288 + (size_t)(c >> 1) * 1024 + (size_t)(((c & 1) * 32 + pi32(kidx & 31)) * 16); }
DI size_t vimg_off(int kidx0, int d) { return (size_t)(kidx0 >> 5) * 8192 + (size_t)((((((kidx0 >> 4) & 1) * 4 + (d >> 5)) * 64) + ((kidx0 >> 3) & 1) * 32 + (d & 31)) * 16); }
constexpr size_t KIMG_BH = (size_t)(NKEY / 32) * 12288, VIMG_BH = (size_t)(NKEY / 32) * 8192;
struct RowInfo { int lat, b, t, kidx, prow, pcol; };
DI RowInfo row_info(int r) { RowInfo q; q.lat = r < NLAT; q.b = q.lat ? (r >> 12) : ((r - NLAT) >> 8); q.t = q.lat ? (r & (SEQ - 1)) : ((r - NLAT) & (CTXL - 1)); q.kidx = q.lat ? q.t : SEQ + q.t; q.prow = q.t >> 6; q.pcol = q.t & 63; return q; }
DI void rope8(float (&y)[8], int d0, const RowInfo& ri, const f32x2* rope) {
    const int seg = d0 >> 5, second = (d0 >> 4) & 1, i0 = d0 & 15; const int pos = seg ? ri.pcol : ri.prow;
#pragma unroll
    for (int j = 0; j < 8; ++j) { const float yp = dppf<0x4E>(y[j]); const f32x2 cs = rope[pos * 16 + i0 + j];
        y[j] = second ? (y[j] * cs.x + yp * cs.y) : (y[j] * cs.x - yp * cs.y); }
}
DI void rope8t(float (&y)[8], int d0, const f32x4 (&rt)[4]) {
    const int second = (d0 >> 4) & 1;
#pragma unroll
    for (int j = 0; j < 8; ++j) { const float yp = dppf<0x4E>(y[j]); const float cx = rt[j >> 1][2 * (j & 1)], cy = rt[j >> 1][2 * (j & 1) + 1];
        y[j] = second ? (y[j] * cx + yp * cy) : (y[j] * cx - yp * cy); }
}
#ifndef PREP_ABL
#define PREP_ABL 0
#endif
DI void prep_phase(const Args& a, Frame& F, int l, int rep = 0) {
    const bool skipA = rep > 0 && (PREP_ABL & 1), skipB = rep > 0 && (PREP_ABL & 2);
    unsigned char* ws = a.ws;
    const bf16* P = (const bf16*)(ws + WS_P);
    const f32x2* rope = (const f32x2*)(ws + WS_ROPE);
    const float* g_qa = inp(F, I_QAN) + l * 512, *g_kva = inp(F, I_KVAN) + l * 256, *g_kr = inp(F, I_KRN) + l * 64;
    const float* g_sq = inp(F, I_SQN) + l * 64, *g_sk = inp(F, I_SKN) + l * 64, *g_nq = inp(F, I_NQN) + l * 64, *g_nk = inp(F, I_NKN) + l * 64;
    const int lane = F.lane;
    float gq_qa[8], gq_sq[8], gq_sk[8], gq_nq[8], gq_nk[8];
    { const int d0h = (lane & 7) * 8;
#pragma unroll
      for (int j = 0; j < 8; ++j) { gq_qa[j] = g_qa[lane * 8 + j]; gq_sq[j] = g_sq[d0h + j]; gq_sk[j] = g_sk[d0h + j]; gq_nq[j] = g_nq[d0h + j]; gq_nk[j] = g_nk[d0h + j]; } }
    const f32x4 gq_kva = *(const f32x4*)(g_kva + lane * 4); const float gq_kr = g_kr[lane];
    for (int r = F.gw; r < (skipA ? 0 : NROW); r += F.ngw) {
        const RowInfo ri = row_info(r); const bf16* prow = P + (size_t)r * INP;
        const int l16 = lane & 15, d0 = (lane & 7) * 8;
        const bf16x8 v_cq = *(const bf16x8*)(prow + C_CQ + lane * 8);
        const v2u v_ckv = *(const v2u*)(prow + C_CKV + lane * 4);
        const float x_kr = bf2f(prow[C_KR + lane]);
        const bf16x8 v_pool = *(const bf16x8*)(prow + C_POOL + lane * 8);
        const bf16x8 v_sq = *(const bf16x8*)(prow + C_SQ + lane * 8);
        const bf16x8 v_sk = *(const bf16x8*)(prow + C_SK + l16 * 8);
        const bf16x8 v_nq = *(const bf16x8*)(prow + C_NQ + lane * 8);
        const bf16x8 v_nk = *(const bf16x8*)(prow + C_NK + lane * 8);
        f32x2 kcs = {1.f, 0.f}; if (ri.lat) kcs = rope[((lane & 32) ? ri.pcol : ri.prow) * 16 + (lane & 15)];
        f32x4 rt[4];
        { const int d0r = (lane & 7) * 8; const f32x4* rp = (const f32x4*)(rope + ((d0r >> 5) ? ri.pcol : ri.prow) * 16 + (d0r & 15));
#pragma unroll
          for (int k = 0; k < 4; ++k) rt[k] = ri.lat ? rp[k] : (f32x4){1.f, 0.f, 1.f, 0.f}; }
        { const int g = lane >> 4, hw = 1 << g, n = ri.lat ? SEQ : CTXL; const int lo = max(ri.t - hw, 0), hi = min(ri.t + hw, n);
          float s[8];
#pragma unroll
          for (int j = 0; j < 8; ++j) s[j] = 0.f;
          const bf16* pb = P + (size_t)(r - ri.t) * INP + C_POOL + lane * 8;
          bf16x8 wv[16];
#pragma unroll
          for (int q = 0; q < 16; ++q) wv[q] = *(const bf16x8*)(pb + (size_t)min(lo + q, hi - 1) * INP);
#pragma unroll
          for (int q = 0; q < 16; ++q) { float f[8]; unpack8(wv[q], f); const float msk = (lo + q < hi) ? 1.0f : 0.0f;
#pragma unroll
              for (int j = 0; j < 8; ++j) s[j] += msk * f[j]; }
          float f[8]; unpack8(v_pool, f); const float inv = __builtin_amdgcn_rcpf((float)(hi - lo));
#pragma unroll
          for (int j = 0; j < 8; ++j) s[j] = s[j] * inv - f[j];
          *(v4u*)((bf16*)(ws + WS_MIX) + (size_t)r * DM + 512 + lane * 8) = pack8(s); }
        { float f[8]; unpack8(v_cq, f); float ss = 0.f;
#pragma unroll
          for (int j = 0; j < 8; ++j) ss += f[j] * f[j];
          const float rstd = __builtin_amdgcn_rsqf(wave_sum(ss) * (1.0f / 512) + EPS);
#pragma unroll
          for (int j = 0; j < 8; ++j) f[j] = f[j] * rstd * gq_qa[j];
          *(v4u*)((bf16*)(ws + WS_QN) + (size_t)r * 512 + lane * 8) = pack8(f); }
        { const v2u w = v_ckv; float f0 = bflo(w.x), f1 = bfhi(w.x), f2 = bflo(w.y), f3 = bfhi(w.y);
          const float rstd = __builtin_amdgcn_rsqf(wave_sum(f0 * f0 + f1 * f1 + f2 * f2 + f3 * f3) * (1.0f / 256) + EPS);
          const f32x4 gg = gq_kva;
          v2u o; o.x = pk2(f0 * rstd * gg.x, f1 * rstd * gg.y); o.y = pk2(f2 * rstd * gg.z, f3 * rstd * gg.w);
          *(v2u*)((bf16*)(ws + WS_KVN) + (size_t)r * 256 + lane * 4) = o; }
        { const float x = x_kr; const float rstd = __builtin_amdgcn_rsqf(wave_sum(x * x) * (1.0f / 64) + EPS);
          float y = x * rstd * gq_kr;
          const float yp = bperm(y, lane ^ 16);
          if (ri.lat) { const f32x2 cs = kcs;
              y = (lane & 16) ? (y * cs.x + yp * cs.y) : (y * cs.x - yp * cs.y); }
          float e[8];
#pragma unroll
          for (int j = 0; j < 8; ++j) e[j] = bperm(y, (lane & ~7) + j);
          if ((lane & 7) == 0) { const v4u o = pack8(e);
#pragma unroll
              for (int h = 0; h < 4; ++h) *(v4u*)(ws + WS_KMLA + (size_t)(ri.b * 4 + h) * KIMG_BH + kimg_off(ri.kidx, 16 + (lane >> 3))) = o; } }
        { float f[8]; unpack8(v_sq, f); float ss = 0.f;
#pragma unroll
          for (int j = 0; j < 8; ++j) ss += f[j] * f[j];
          ss = sum8(ss);
          const float rstd = __builtin_amdgcn_rsqf(ss * (1.0f / 64) + EPS);
#pragma unroll
          for (int j = 0; j < 8; ++j) f[j] = f[j] * rstd * gq_sq[j];
          if (ri.lat) rope8t(f, d0, rt);
          *(v4u*)((bf16*)(ws + WS_QSWA) + ((size_t)(ri.b * 8 + (lane >> 3)) * NKEY + ri.kidx) * 64 + d0) = pack8(f); }
        { float f[8]; unpack8(v_sk, f); float ss = 0.f;
#pragma unroll
          for (int j = 0; j < 8; ++j) ss += f[j] * f[j];
          ss = sum8(ss);
          const float rstd = __builtin_amdgcn_rsqf(ss * (1.0f / 64) + EPS);
#pragma unroll
          for (int j = 0; j < 8; ++j) f[j] = f[j] * rstd * gq_sk[j];
          if (ri.lat) rope8t(f, d0, rt);
          if (lane < 16) *(v4u*)((bf16*)(ws + WS_KSWA) + ((size_t)(ri.b * 2 + (lane >> 3)) * NKEY + ri.kidx) * 64 + d0) = pack8(f); }
        { float f[8]; unpack8(v_nq, f); float ss = 0.f;
#pragma unroll
          for (int j = 0; j < 8; ++j) ss += f[j] * f[j];
          ss = sum8(ss);
          const float rstd = __builtin_amdgcn_rsqf(ss * (1.0f / 64) + EPS);
#pragma unroll
          for (int j = 0; j < 8; ++j) f[j] = f[j] * rstd * gq_nq[j];
          *(v4u*)((bf16*)(ws + WS_QNA) + ((size_t)(ri.b * 8 + (lane >> 3)) * NKEY + ri.kidx) * 64 + d0) = pack8(f); }
        { float f[8]; unpack8(v_nk, f); float ss = 0.f;
#pragma unroll
          for (int j = 0; j < 8; ++j) ss += f[j] * f[j];
          ss = sum8(ss);
          const float rstd = __builtin_amdgcn_rsqf(ss * (1.0f / 64) + EPS);
#pragma unroll
          for (int j = 0; j < 8; ++j) f[j] = f[j] * rstd * gq_nk[j];
          *(v4u*)((bf16*)(ws + WS_KNA) + ((size_t)(ri.b * 8 + (lane >> 3)) * NKEY + ri.kidx) * 64 + d0) = pack8(f); }
    }
    const int nitB = skipB ? 0 : (NROW / 8) * 5;
    unsigned e[8];
    if (F.gw < nitB) { const int g0 = F.gw / 5, c0 = F.gw % 5; const bf16* s0 = P + (size_t)(g0 * 8) * INP + (c0 == 0 ? C_SV : C_NV + (c0 - 1) * 128) + 2 * lane;
#pragma unroll
        for (int k = 0; k < 8; ++k) e[k] = *(const unsigned*)(s0 + (size_t)k * INP); }
    for (int it = F.gw; it < nitB; it += F.ngw) {
        const int grp = it / 5, ch = it % 5; const int r0 = grp * 8; const RowInfo ri = row_info(r0);
        unsigned en[8];
        { const int nx = it + F.ngw; const int gn = nx / 5, cn = nx % 5; const bf16* sn = P + (size_t)(gn * 8) * INP + (cn == 0 ? C_SV : C_NV + (cn - 1) * 128) + 2 * lane;
#pragma unroll
          for (int k = 0; k < 8; ++k) en[k] = nx < nitB ? *(const unsigned*)(sn + (size_t)k * INP) : 0u; }
        v4u lo, hi;
        lo.x = (e[0] & 0xffffu) | (e[1] << 16); lo.y = (e[2] & 0xffffu) | (e[3] << 16); lo.z = (e[4] & 0xffffu) | (e[5] << 16); lo.w = (e[6] & 0xffffu) | (e[7] << 16);
        hi.x = (e[0] >> 16) | (e[1] & 0xffff0000u); hi.y = (e[2] >> 16) | (e[3] & 0xffff0000u); hi.z = (e[4] >> 16) | (e[5] & 0xffff0000u); hi.w = (e[6] >> 16) | (e[7] & 0xffff0000u);
        const int dd = 2 * lane, hsel = dd >> 6, d = dd & 63;
        bf16* dst = ch == 0 ? (bf16*)(ws + WS_VTSWA) + ((size_t)(ri.b * 2 + hsel) * 64 + d) * NKEY + ri.kidx : (bf16*)(ws + WS_VTNA) + ((size_t)(ri.b * 8 + (ch - 1) * 2 + hsel) * 64 + d) * NKEY + ri.kidx;
        *(v4u*)dst = lo; *(v4u*)(dst + NKEY) = hi;
#pragma unroll
        for (int k = 0; k < 8; ++k) e[k] = en[k];
    }
}

namespace pg8 {
struct EpiMlaKV {
    static constexpr bool PERM = true, AFTER_DRAIN = false, PERMA = true;
    unsigned char* KI; unsigned char* VI; const float* gkn; PG8_LAS float* XB;
    __device__ __forceinline__ void operator()(const f32x4 (&acc)[2][2][4][2], const Unit& u, int wr, int wc, int, int) const {
        const int lane = fresh_lane(), fr = lane & 15, fq = lane >> 4, head = u.pn;
        PG8_LAS float* P = XB;
#pragma unroll
        for (int ai = 0; ai < 2; ++ai)
#pragma unroll
            for (int m = 0; m < 4; ++m) { const f32x4 a0 = acc[ai][0][m][0], a1 = acc[ai][0][m][1];
                float s = ((a0[0] * a0[0] + a0[1] * a0[1]) + (a0[2] * a0[2] + a0[3] * a0[3])) + ((a1[0] * a1[0] + a1[1] * a1[1]) + (a1[2] * a1[2] + a1[3] * a1[3]));
                s += __builtin_bit_cast(float, __builtin_amdgcn_ds_bpermute((lane ^ 16) << 2, __builtin_bit_cast(int, s))); s += __builtin_bit_cast(float, __builtin_amdgcn_ds_bpermute((lane ^ 32) << 2, __builtin_bit_cast(int, s)));
                if (fq == 0) P[(ai * HALF + wr * 64 + fr * 4 + m) * 4 + wc] = s; }
        asm volatile("s_waitcnt lgkmcnt(0)\n\ts_barrier" ::: "memory");
        const int dk = wc * 32 + 8 * fq;
        const f32x4 g0 = *(const f32x4*)(gkn + dk), g1 = *(const f32x4*)(gkn + dk + 4);
#pragma unroll
        for (int ai = 0; ai < 2; ++ai) {
            const int rbase = u.pm * BM + ai * HALF + wr * 64;
            const RowInfo rb = row_info(rbase);
            unsigned char* kb = KI + (size_t)(rb.b * 4 + head) * KIMG_BH; unsigned char* vb = VI + (size_t)(rb.b * 4 + head) * VIMG_BH;
#pragma unroll
            for (int m = 0; m < 4; ++m) { const int rl = ai * HALF + wr * 64 + fr * 4 + m; const f32x4 p = *(const PG8_LAS f32x4*)(P + rl * 4);
                const float rstd = __builtin_amdgcn_rsqf(((p[0] + p[1]) + (p[2] + p[3])) * (1.0f / 128) + EPS);
                const f32x4 y0 = (acc[ai][0][m][0] * rstd) * g0, y1 = (acc[ai][0][m][1] * rstd) * g1;
                u32x4 w; w.x = cvt_pk_bf16(y0[0], y0[1]); w.y = cvt_pk_bf16(y0[2], y0[3]); w.z = cvt_pk_bf16(y1[0], y1[1]); w.w = cvt_pk_bf16(y1[2], y1[3]);
                *(u32x4*)(kb + kimg_off(rb.kidx + fr * 4 + m, wc * 4 + fq)) = w; }
            const bool odd = (fr & 1) != 0; const int kidx0 = rb.kidx + (fr & ~1) * 4;
#pragma unroll
            for (int j = 0; j < 4; ++j) {
                const unsigned n0lo = cvt_pk_bf16(acc[ai][1][0][0][j], acc[ai][1][1][0][j]), n0hi = cvt_pk_bf16(acc[ai][1][2][0][j], acc[ai][1][3][0][j]);
                const unsigned n1lo = cvt_pk_bf16(acc[ai][1][0][1][j], acc[ai][1][1][1][j]), n1hi = cvt_pk_bf16(acc[ai][1][2][1][j], acc[ai][1][3][1][j]);
                const unsigned slo = odd ? n0lo : n1lo, shi = odd ? n0hi : n1hi;
                const unsigned rlo = (unsigned)__builtin_amdgcn_update_dpp(0, (int)slo, 0xB1, 0xf, 0xf, false), rhi = (unsigned)__builtin_amdgcn_update_dpp(0, (int)shi, 0xB1, 0xf, 0xf, false);
                u32x4 w; if (odd) { w.x = rlo; w.y = rhi; w.z = n1lo; w.w = n1hi; } else { w.x = n0lo; w.y = n0hi; w.z = rlo; w.w = rhi; }
                *(u32x4*)(vb + vimg_off(kidx0, dk + (odd ? 4 : 0) + j)) = w; }
        }
    }
};
struct EpiMlaQ {
    static constexpr bool PERM = true, AFTER_DRAIN = false, PERMA = false;
    bf16_t* QM; const float* gqn; const float* gqr; const f32x2* rope; PG8_LAS float* XB;
    __device__ __forceinline__ void operator()(const f32x4 (&acc)[2][2][4][2], const Unit& u, int wr, int wc, int, int) const {
        const int lane = fresh_lane(), fr = lane & 15, fq = lane >> 4;
        const bool isrope = u.pn == 2;
        PG8_LAS float* P = XB;
#pragma unroll
        for (int ai = 0; ai < 2; ++ai)
#pragma unroll
            for (int m = 0; m < 4; ++m)
#pragma unroll
                for (int bj = 0; bj < 2; ++bj) { const f32x4 a0 = acc[ai][bj][m][0], a1 = acc[ai][bj][m][1];
                    float s = ((a0[0] * a0[0] + a0[1] * a0[1]) + (a0[2] * a0[2] + a0[3] * a0[3])) + ((a1[0] * a1[0] + a1[1] * a1[1]) + (a1[2] * a1[2] + a1[3] * a1[3]));
                    s += __builtin_bit_cast(float, __builtin_amdgcn_ds_bpermute((lane ^ 16) << 2, __builtin_bit_cast(int, s))); s += __builtin_bit_cast(float, __builtin_amdgcn_ds_bpermute((lane ^ 32) << 2, __builtin_bit_cast(int, s)));
                    if (fq == 0) P[(ai * HALF + wr * 64 + m * 16 + fr) * 8 + bj * 4 + wc] = s; }
        asm volatile("s_waitcnt lgkmcnt(0)\n\ts_barrier" ::: "memory");
        const int dk = wc * 32 + 8 * fq, dr = (wc & 1) * 32 + 4 * fq;
        const f32x4 g0 = isrope ? *(const f32x4*)(gqr + dr) : *(const f32x4*)(gqn + dk), g1 = isrope ? *(const f32x4*)(gqr + dr + 16) : *(const f32x4*)(gqn + dk + 4);
        const bool roped = isrope && u.pm < 32;
        float zz = 0.f; asm volatile("" : "+v"(zz));
        f32x4 nt0 = {zz, zz, zz, zz}, nt1 = nt0;
        if (roped) { const RowInfo r0 = row_info(u.pm * BM + wr * 64 + fr); const f32x4* rp = (const f32x4*)(rope + ((wc & 1) ? r0.pcol : r0.prow) * 16 + 4 * fq); nt0 = rp[0]; nt1 = rp[1]; }
#pragma unroll
        for (int r8 = 0; r8 < 8; ++r8) { const int ai = r8 >> 2, m = r8 & 3;
            const int rl = ai * HALF + wr * 64 + m * 16 + fr; const RowInfo ri = row_info(u.pm * BM + rl);
            const f32x4 t0 = nt0, t1 = nt1;
            asm volatile("" ::: "memory");
            if (roped && r8 < 7) { const RowInfo rn = row_info(u.pm * BM + ((r8 + 1) >> 2) * HALF + wr * 64 + ((r8 + 1) & 3) * 16 + fr);
                const f32x4* rp = (const f32x4*)(rope + ((wc & 1) ? rn.pcol : rn.prow) * 16 + 4 * fq); nt0 = rp[0]; nt1 = rp[1]; }
            const f32x4 c4 = {roped ? t0[0] : 1.0f, roped ? t0[2] : 1.0f, roped ? t1[0] : 1.0f, roped ? t1[2] : 1.0f}, s4 = {t0[1], t0[3], t1[1], t1[3]};
#pragma unroll
            for (int bj = 0; bj < 2; ++bj) {
                const f32x4 p = *(const PG8_LAS f32x4*)(P + rl * 8 + bj * 4);
                const float ss = isrope ? (wc < 2 ? p[0] + p[1] : p[2] + p[3]) : (p[0] + p[1]) + (p[2] + p[3]);
                const float rstd = __builtin_amdgcn_rsqf(ss * (isrope ? 1.0f / 64 : 1.0f / 128) + EPS);
                f32x4 y0 = (acc[ai][bj][m][0] * rstd) * g0, y1 = (acc[ai][bj][m][1] * rstd) * g1;
                u32x4 w;
                if (isrope) { const f32x4 r0 = y0 * c4 - y1 * s4, r1 = y1 * c4 + y0 * s4;
                    w.x = cvt_pk_bf16(r0[0], r0[1]); w.y = cvt_pk_bf16(r0[2], r0[3]); w.z = cvt_pk_bf16(r1[0], r1[1]); w.w = cvt_pk_bf16(r1[2], r1[3]);
                    bf16_t* qp = QM + ((size_t)(ri.b * 4 + bj * 2 + (wc >> 1)) * NKEY + ri.kidx) * 192 + 128 + dr;
                    typedef unsigned u32x2 __attribute__((ext_vector_type(2)));
                    *(u32x2*)qp = (u32x2){w.x, w.y}; *(u32x2*)(qp + 16) = (u32x2){w.z, w.w};
                } else { w.x = cvt_pk_bf16(y0[0], y0[1]); w.y = cvt_pk_bf16(y0[2], y0[3]); w.z = cvt_pk_bf16(y1[0], y1[1]); w.w = cvt_pk_bf16(y1[2], y1[3]);
                    *(u32x4*)(QM + ((size_t)(ri.b * 4 + u.pn * 2 + bj) * NKEY + ri.kidx) * 192 + dk) = w; } } }
    }
};
}

DI void post_phase(const Args& a, Frame& F, int l) {
    unsigned char* ws = a.ws;
    const bf16* QR = (const bf16*)(ws + WS_QRAW); const bf16* KVR = (const bf16*)(ws + WS_KVRAW);
    const f32x2* rope = (const f32x2*)(ws + WS_ROPE);
    const float* g_qn = inp(F, I_QNN) + l * 128, *g_qr = inp(F, I_QRN) + l * 64, *g_kn = inp(F, I_KNN) + l * 128;
    const int lane = F.lane;
    float gq_q[8], gq_k[8];
    { const int li0 = lane & 31; const float* gp0 = li0 >= 16 ? g_qr + ((li0 - 16) & 7) * 8 : g_qn + (li0 & 15) * 8;
#pragma unroll
      for (int j = 0; j < 8; ++j) { gq_q[j] = gp0[j]; gq_k[j] = g_kn[(lane & 15) * 8 + j]; } }
    for (int r = F.gw; r < NROW; r += F.ngw) {
        const RowInfo ri = row_info(r);
        const int li = lane & 31; const bool active = li < 24, isrope = li >= 16;
        const int coff = isrope ? 128 + (li - 16) * 8 : li * 8;
        bf16x8 vq[2];
#pragma unroll
        for (int pp = 0; pp < 2; ++pp) vq[pp] = *(const bf16x8*)(QR + (size_t)r * 768 + (2 * pp + (lane >> 5)) * 192 + (active ? coff : 0));
#pragma unroll
        for (int pp = 0; pp < 2; ++pp) {
            const int head = 2 * pp + (lane >> 5);
            float f[8]; unpack8(vq[pp], f);
            if (!active) {
#pragma unroll
                for (int j = 0; j < 8; ++j) f[j] = 0.f; }
            float ss = 0.f;
#pragma unroll
            for (int j = 0; j < 8; ++j) ss += f[j] * f[j];
            ss = sum8(ss); const float s16 = ss + dppf<0x140>(ss);
            const float rstd = isrope ? __builtin_amdgcn_rsqf(ss * (1.0f / 64) + EPS) : __builtin_amdgcn_rsqf(s16 * (1.0f / 128) + EPS);
#pragma unroll
            for (int j = 0; j < 8; ++j) f[j] = f[j] * rstd * gq_q[j];
            if (ri.lat) { float y[8];
#pragma unroll
                for (int j = 0; j < 8; ++j) y[j] = f[j];
                rope8(y, ((li - 16) & 7) * 8, ri, rope);
                if (isrope) {
#pragma unroll
                    for (int j = 0; j < 8; ++j) f[j] = y[j]; } }
            if (active) *(v4u*)((bf16*)(ws + WS_QMLA) + ((size_t)(ri.b * 4 + head) * NKEY + ri.kidx) * 192 + coff) = pack8(f);
        }
    }
}

#define MFMA32(a, b, c) __builtin_amdgcn_mfma_f32_32x32x16_bf16((a), (b), (c), 0, 0, 0)
typedef __bf16 bf16x2_t __attribute__((ext_vector_type(2)));
DI unsigned cvtpk_s(float lo, float hi) { f32x2 v = {lo, hi}; bf16x2_t b = __builtin_convertvector(v, bf16x2_t); return __builtin_bit_cast(unsigned, b); }
DI int keyof(int i, int h) { return 16 * (i >> 3) + 8 * h + (i & 7); }
DI float xhalf_max(float x) { const unsigned u = __builtin_bit_cast(unsigned, x); auto rr = __builtin_amdgcn_permlane32_swap(u, u, false, false);
    return fmaxf(__builtin_bit_cast(float, (unsigned)rr[0]), __builtin_bit_cast(float, (unsigned)rr[1])); }
DI float xhalf_sum(float x) { const unsigned u = __builtin_bit_cast(unsigned, x); auto rr = __builtin_amdgcn_permlane32_swap(u, u, false, false);
    return __builtin_bit_cast(float, (unsigned)rr[0]) + __builtin_bit_cast(float, (unsigned)rr[1]); }
constexpr float ATT_THR = 8.0f;

template <int DV>
DI void attn_softmax_pv(f32x16& s, const bf16x8 (&vf)[2][DV / 32], float& m, float& l, f32x16 (&o)[DV / 32], const float C = 1.0f) {
    float tmax = fmaxf(s[0], s[1]);
#pragma unroll
    for (int i = 2; i < 16; i += 2) tmax = fmaxf(fmaxf(tmax, s[i]), s[i + 1]);
    tmax = xhalf_max(tmax) * C;
    if (!__all(tmax <= m + ATT_THR)) {
        const float mn = fmaxf(m, tmax); const float alpha = __builtin_amdgcn_exp2f(m - mn); m = mn; l *= alpha;
#pragma unroll
        for (int db = 0; db < DV / 32; ++db)
#pragma unroll
            for (int i = 0; i < 16; ++i) o[db][i] *= alpha;
    }
    float ps = 0.f;
#pragma unroll
    for (int i = 0; i < 16; ++i) { s[i] = __builtin_amdgcn_exp2f(fmaf(s[i], C, -m)); ps += s[i]; }
    ps = xhalf_sum(ps);
    l += ps;
#pragma unroll
    for (int st = 0; st < 2; ++st) {
        v4u pw; pw.x = cvtpk_s(s[8 * st + 0], s[8 * st + 1]); pw.y = cvtpk_s(s[8 * st + 2], s[8 * st + 3]); pw.z = cvtpk_s(s[8 * st + 4], s[8 * st + 5]); pw.w = cvtpk_s(s[8 * st + 6], s[8 * st + 7]);
        const bf16x8 pf = __builtin_bit_cast(bf16x8, pw);
#pragma unroll
        for (int db = 0; db < DV / 32; ++db) o[db] = MFMA32(vf[st][db], pf, o[db]);
    }
}
DI void mla_softmax_pv(f32x16& s, const LAS unsigned char* vt, float& m, float& l, f32x16 (&o)[4], const float C) {
    bf16x8 va[4];
#pragma unroll
    for (int db = 0; db < 4; ++db) va[db] = *(const LAS bf16x8*)(vt + db * 1024);
    float tmax = fmaxf(s[0], s[1]);
#pragma unroll
    for (int i = 2; i < 16; i += 2) tmax = fmaxf(fmaxf(tmax, s[i]), s[i + 1]);
    tmax = xhalf_max(tmax) * C;
    if (!__all(tmax <= m + ATT_THR)) {
        const float mn = fmaxf(m, tmax); const float alpha = __builtin_amdgcn_exp2f(m - mn); m = mn; l *= alpha;
#pragma unroll
        for (int db = 0; db < 4; ++db)
#pragma unroll
            for (int i = 0; i < 16; ++i) o[db][i] *= alpha;
    }
    float ps = 0.f;
#pragma unroll
    for (int i = 0; i < 16; ++i) { s[i] = __builtin_amdgcn_exp2f(fmaf(s[i], C, -m)); ps += s[i]; }
    ps = xhalf_sum(ps);
    l += ps;
    { v4u pw; pw.x = cvtpk_s(s[0], s[1]); pw.y = cvtpk_s(s[2], s[3]); pw.z = cvtpk_s(s[4], s[5]); pw.w = cvtpk_s(s[6], s[7]);
      const bf16x8 pf = __builtin_bit_cast(bf16x8, pw);
#pragma unroll
      for (int db = 0; db < 4; ++db) o[db] = MFMA32(va[db], pf, o[db]); }
    asm volatile("" ::: "memory");
#pragma unroll
    for (int db = 0; db < 4; ++db) va[db] = *(const LAS bf16x8*)(vt + (4 + db) * 1024);
    { v4u pw; pw.x = cvtpk_s(s[8], s[9]); pw.y = cvtpk_s(s[10], s[11]); pw.z = cvtpk_s(s[12], s[13]); pw.w = cvtpk_s(s[14], s[15]);
      const bf16x8 pf = __builtin_bit_cast(bf16x8, pw);
#pragma unroll
      for (int db = 0; db < 4; ++db) o[db] = MFMA32(va[db], pf, o[db]); }
}
template <int DV>
DI void attn_store(const f32x16 (&o)[DV / 32], float l, bf16* orow, int h) {
    const float inv = 1.0f / l;
#pragma unroll
    for (int db = 0; db < DV / 32; ++db)
#pragma unroll
        for (int g0 = 0; g0 < 4; g0 += 2) {
            const unsigned ax = pk2(o[db][4 * g0] * inv, o[db][4 * g0 + 1] * inv), ay = pk2(o[db][4 * g0 + 2] * inv, o[db][4 * g0 + 3] * inv);
            const unsigned bx = pk2(o[db][4 * g0 + 4] * inv, o[db][4 * g0 + 5] * inv), by = pk2(o[db][4 * g0 + 6] * inv, o[db][4 * g0 + 7] * inv);
            auto rx = __builtin_amdgcn_permlane32_swap(ax, bx, false, false); auto ry = __builtin_amdgcn_permlane32_swap(ay, by, false, false);
            v4u w; w.x = (unsigned)rx[0]; w.y = (unsigned)ry[0]; w.z = (unsigned)rx[1]; w.w = (unsigned)ry[1];
            *(v4u*)(orow + 32 * db + 8 * (g0 + h)) = w; }
}
template <int DQK> DI void load_q(bf16x8 (&qf)[DQK / 16], const bf16* qrow, int h) {
#pragma unroll
    for (int kk = 0; kk < DQK / 16; ++kk) qf[kk] = *(const bf16x8*)(qrow + 16 * kk + 8 * h);
}
template <int DV> DI void zero_o(f32x16 (&o)[DV / 32]) {
#pragma unroll
    for (int db = 0; db < DV / 32; ++db)
#pragma unroll
        for (int i = 0; i < 16; ++i) o[db][i] = 0.f;
}

struct Tile64 { bf16x8 kf[4]; bf16x8 vf[2][2]; };
DI void load_tile64(Tile64& T, const bf16* kb, const bf16* vb, int key0) {
#pragma unroll
    for (int kk = 0; kk < 4; ++kk) T.kf[kk] = *(const bf16x8*)(kb + (size_t)key0 * 64 + 16 * kk);
#pragma unroll
    for (int st = 0; st < 2; ++st)
#pragma unroll
        for (int db = 0; db < 2; ++db) T.vf[st][db] = *(const bf16x8*)(vb + (size_t)(32 * db) * NKEY + key0 + 16 * st);
}
struct Adj64 { int mode; int p0, p1, p2; const LAS float* rpb; };
DI void adjust64(f32x16& s, const Adj64& A, int key0, int h, int ql) {
    const int qp = A.p0 + ql;
#pragma unroll
    for (int i = 0; i < 16; ++i) { const int d = key0 + keyof(i, h) - qp; if (d > 128 || d < -128) s[i] = -__builtin_inff(); }
}
DI void adjust64_na(f32x16& s, const Adj64& A, int key0, int h, int ql, float C) {
    const int rq = A.p0 + (ql >> 4), cq = A.p1 * 16 + (ql & 15), kr = key0 >> 6, coloff = key0 & 63; const int r0 = min(max(rq - 4, 0), 56), c0 = min(max(cq - 8, 0), 48);
    const int rowb = ((kr >= r0 && kr < r0 + 8) ? (kr - rq + 7) : 15) * 128;
    const LAS unsigned char* tb = (const LAS unsigned char*)A.rpb + rowb;
    int bcol = coloff + 8 * h - cq + 15, bval = coloff + 8 * h - c0;
    asm volatile("" : "+v"(bcol), "+v"(bval));
#pragma unroll
    for (int i = 0; i < 16; ++i) { if (i == 8) asm volatile("" ::: "memory"); const int ci = 16 * (i >> 3) + (i & 7); const int off = ((unsigned)(bval + ci) < 16u) ? (bcol + ci) * 4 : 124;
        s[i] = fmaf(s[i], C, *(const LAS float*)(tb + off)); }
}
struct U64 {
    const bf16* qrow; const bf16* Kb; const bf16* Vb;
    int nloc, lstart;
    int mode, p0, p1, lo, hi, coloff;
    const float* rpb; float m0, l0; bf16* orow;
};
DI void tile64_lds(const LAS unsigned char* st, int off, const bf16x8 (&qf)[4], const Adj64& A, bool adj, int key0, float& m, float& lsum, f32x16 (&o)[2], int h, int ql, int pq) {
    int pq_ = pq, ql_ = ql; asm volatile("" : "+v"(pq_), "+v"(ql_));
    const int key = off + pq_; const int ka = key * 128, ksw = (key >> 1) & 7, vsw = (ql_ >> 1) & 7, kc0 = (off >> 3) + h;
    f32x16 s;
#pragma unroll
    for (int i = 0; i < 16; ++i) s[i] = 0.f;
#pragma unroll
    for (int kk = 0; kk < 4; ++kk) { const bf16x8 kf = *(const LAS bf16x8*)(st + ka + (((2 * kk + h) ^ ksw) << 4)); s = MFMA32(kf, qf[kk], s); }
    bf16x8 vf[2][2];
#pragma unroll
    for (int t = 0; t < 2; ++t)
#pragma unroll
        for (int db = 0; db < 2; ++db) vf[t][db] = *(const LAS bf16x8*)(st + 8192 + (32 * db + ql_) * 128 + (((kc0 + 2 * t) ^ vsw) << 4));
    const float C = 0.125f * LOG2E;
    if (adj) {
        if (A.mode == 2) adjust64_na(s, A, key0, h, ql, C);
        else {
#pragma unroll
            for (int i = 0; i < 16; ++i) s[i] *= C;
            adjust64(s, A, key0, h, ql); }
        attn_softmax_pv<64>(s, vf, m, lsum, o);
    } else attn_softmax_pv<64>(s, vf, m, lsum, o, C);
}
DI void run_wg64(Frame& F, const U64& U, int h, int ql) {
    const int lane = F.lane, pq = pi32(ql);
    bf16x8 qf[4]; load_q<64>(qf, U.qrow, h);
    f32x16 o[2]; zero_o<64>(o); float m = U.m0, lsum = U.l0;
    const LAS float* rtab = (const LAS float*)(F.lds + RING_OFF + 49152);
    const Adj64 A{U.mode, U.p0, U.p1, 0, rtab};
    const int nsteps = 4 + U.nloc;
    size_t goff[2]; const bf16* gb[2];
#pragma unroll
    for (int jj = 0; jj < 2; ++jj) { const int pp = F.wave * 2 + jj; const int row = 8 * (pp & 7) + (lane >> 3); const int ch = (lane & 7) ^ ((row >> 1) & 7);
        if (pp < 8) { gb[jj] = U.Kb; goff[jj] = (size_t)row * 64 + ch * 8; } else { gb[jj] = U.Vb; goff[jj] = (size_t)row * NKEY + ch * 8; } }
    const bool kp0 = (F.wave * 2) < 8;
#define U64_ISSUE(step) do { const int s_ = (step); const int bk_ = s_ < 4 ? SEQ + 64 * s_ : U.lstart + 64 * (s_ - 4); const size_t ko_ = kp0 ? (size_t)bk_ * 64 : (size_t)bk_; \
        _Pragma("unroll") for (int jj = 0; jj < 2; ++jj) __builtin_amdgcn_global_load_lds((const unsigned*)(gb[jj] + goff[jj] + ko_), (LAS unsigned*)(F.lds + RING_OFF + (s_ % 3) * 16384 + (F.wave * 2 + jj) * 1024), 16, 0, 0); } while (0)
    __syncthreads();
    if (U.mode == 2) { const int r = F.tid >> 5, c = F.tid & 31; ((LAS float*)(F.lds + RING_OFF + 49152))[F.tid] = (r < 15 && c < 31) ? U.rpb[r * 31 + c] * LOG2E : -__builtin_inff(); }
    U64_ISSUE(0); if (nsteps > 1) U64_ISSUE(1);
    for (int i = 0; i < nsteps; ++i) {
        if (i + 1 < nsteps) asm volatile("s_waitcnt vmcnt(2) lgkmcnt(0)\n\ts_barrier" ::: "memory"); else asm volatile("s_waitcnt vmcnt(0) lgkmcnt(0)\n\ts_barrier" ::: "memory");
        if (i + 2 < nsteps) U64_ISSUE(i + 2);
        const LAS unsigned char* st = F.lds + RING_OFF + (i % 3) * 16384;
        const int bk = i < 4 ? SEQ + 64 * i : U.lstart + 64 * (i - 4);
        if (i < 4) { tile64_lds(st, 0, qf, A, false, bk, m, lsum, o, h, ql, pq); tile64_lds(st, 32, qf, A, false, bk + 32, m, lsum, o, h, ql, pq); }
        else if (U.mode == 1) {
            if (bk >= U.lo && bk <= U.hi) tile64_lds(st, 0, qf, A, !(bk >= U.p0 - 97 && bk <= U.p0 + 97), bk, m, lsum, o, h, ql, pq);
            if (bk + 32 >= U.lo && bk + 32 <= U.hi) tile64_lds(st, 32, qf, A, !(bk + 32 >= U.p0 - 97 && bk + 32 <= U.p0 + 97), bk + 32, m, lsum, o, h, ql, pq);
        } else { const int kr = bk >> 6; if (kr >= U.lo && kr <= U.hi) tile64_lds(st, U.coloff, qf, A, true, bk + U.coloff, m, lsum, o, h, ql, pq); }
    }
#undef U64_ISSUE
    attn_store<64>(o, lsum, U.orow, h);
}

#ifndef PH_DUP
#define PH_DUP 0
#endif
#define ATT_REP1 (1 + (((PH_DUP) >> 12) & 1))
#define ATT_REP2 (1 + (((PH_DUP) >> 13) & 1))
DI void attn_phase(const Args& a, Frame& F, int l, bool do_ctx) {
    unsigned char* ws = a.ws;
    const bf16* QM = (const bf16*)(ws + WS_QMLA); const unsigned char* KI = ws + WS_KMLA; const unsigned char* VI = ws + WS_VTMLA;
    const bf16* QS = (const bf16*)(ws + WS_QSWA); const bf16* KS = (const bf16*)(ws + WS_KSWA); const bf16* VS = (const bf16*)(ws + WS_VTSWA);
    const bf16* QN_ = (const bf16*)(ws + WS_QNA); const bf16* KN_ = (const bf16*)(ws + WS_KNA); const bf16* VN_ = (const bf16*)(ws + WS_VTNA);
    bf16* MIX = (bf16*)(ws + WS_MIX);
    const int lane = F.lane, ql = lane & 31, h = lane >> 5;
    const float C_MLA = 0.07216878364870322f * LOG2E;
    constexpr int STAGE = 40960, TILEB = 20480, NSTEP = NKEY / 64, HSTEP = NSTEP / 2;
    unsigned* pflag = (unsigned*)(ws + WS_CTL) + CW_PAIR; float* ppart = (float*)(ws + WS_AUP);
    for (int rep1 = 0; rep1 < ATT_REP1; ++rep1)
    for (int u = blockIdx.x; u < 256; u += gridDim.x) {
        const int pair = u & 127, kz = 1 - (u >> 7); const int b = (pair >> 2) & 1, hd = pair & 3, qb = pair >> 3;
        const int bh = b * 4 + hd; const int tq = qb * 256 + F.wave * 32 + ql;
        bf16x8 qf[12]; load_q<192>(qf, QM + ((size_t)bh * NKEY + tq) * 192, h);
        f32x16 o[4]; zero_o<128>(o); float m = -1e30f, lsum = 0.f;
        const unsigned char* kimg = KI + (size_t)bh * KIMG_BH + (size_t)(kz * HSTEP) * 24576 + lane * 16; const unsigned char* vimg = VI + (size_t)bh * VIMG_BH + (size_t)(kz * HSTEP) * 16384 + lane * 16;
        __syncthreads();
        const int kp1 = F.wave + 8, kp2 = F.wave + 16;
        const int kd0 = F.wave * 1024, kd1 = (kp1 / 12) * TILEB + (kp1 % 12) * 1024, kd2 = (kp2 / 12) * TILEB + (kp2 % 12) * 1024, vd0 = 12288 + F.wave * 1024;
#define MLA_ISSUE(step, stage) do { const unsigned char* ks_ = kimg + (size_t)(step) * 24576 + F.wave * 1024; const unsigned char* vs_ = vimg + (size_t)(step) * 16384 + F.wave * 1024; \
            LAS unsigned char* sb_ = F.lds + RING_OFF + (stage) * STAGE; \
            __builtin_amdgcn_global_load_lds((const unsigned*)ks_, (LAS unsigned*)(sb_ + kd0), 16, 0, 0); \
            __builtin_amdgcn_global_load_lds((const unsigned*)(ks_ + 8192), (LAS unsigned*)(sb_ + kd1), 16, 0, 0); \
            __builtin_amdgcn_global_load_lds((const unsigned*)(ks_ + 16384), (LAS unsigned*)(sb_ + kd2), 16, 0, 0); \
            __builtin_amdgcn_global_load_lds((const unsigned*)vs_, (LAS unsigned*)(sb_ + vd0), 16, 0, 0); \
            __builtin_amdgcn_global_load_lds((const unsigned*)(vs_ + 8192), (LAS unsigned*)(sb_ + TILEB + vd0), 16, 0, 0); } while (0)
        MLA_ISSUE(0, 0);
        for (int i = 0; i < HSTEP; ++i) {
            VM_WAIT(); __syncthreads();
            if (i + 1 < HSTEP) MLA_ISSUE(i + 1, (i + 1) & 1);
#pragma unroll
            for (int t = 0; t < 2; ++t) {
                const LAS unsigned char* tb = F.lds + RING_OFF + (i & 1) * STAGE + t * TILEB + lane * 16;
                f32x16 s;
#pragma unroll
                for (int j = 0; j < 16; ++j) s[j] = 0.f;
#pragma unroll
                for (int kk = 0; kk < 12; ++kk) { const bf16x8 kf = *(const LAS bf16x8*)(tb + kk * 1024); s = MFMA32(kf, qf[kk], s); }
                mla_softmax_pv(s, tb + 12288, m, lsum, o, C_MLA);
            }
        }
#undef MLA_ISSUE
        f32x4* mg = (f32x4*)(ppart + ((size_t)pair * 8 + F.wave) * (68 * 64)) + lane; asm volatile("" : "+v"(mg));
        if (kz == 1) {
#pragma unroll
            for (int db = 0; db < 4; ++db)
#pragma unroll
                for (int q = 0; q < 4; ++q) mg[(db * 4 + q) * 64] = (f32x4){o[db][4 * q], o[db][4 * q + 1], o[db][4 * q + 2], o[db][4 * q + 3]};
            mg[16 * 64] = (f32x4){m, lsum, 0.f, 0.f};
            VM_WAIT(); __syncthreads();
            if (F.wave == 0 && lane == 0) { __builtin_amdgcn_fence(__ATOMIC_RELEASE, "agent"); VM_WAIT(); (void)__hip_atomic_fetch_add(pflag + 16 * pair, 1u, __ATOMIC_RELAXED, __HIP_MEMORY_SCOPE_AGENT); }
        } else {
            if (F.wave == 0) { unsigned sp = 0u;
                while ((unsigned)__builtin_amdgcn_readfirstlane(__hip_atomic_load(pflag + 16 * pair, __ATOMIC_RELAXED, __HIP_MEMORY_SCOPE_AGENT)) < (unsigned)(l + 1) * ATT_REP1) { __builtin_amdgcn_s_sleep(2); if (++sp > (1u << 20)) break; }
                __builtin_amdgcn_fence(__ATOMIC_ACQUIRE, "agent"); }
            VM_WAIT(); __syncthreads();
            const f32x4 ml = mg[16 * 64]; const float m1 = ml[0], l1 = ml[1]; const float mn = fmaxf(m, m1); const float a0 = __builtin_amdgcn_exp2f(m - mn), a1 = __builtin_amdgcn_exp2f(m1 - mn);
            lsum = lsum * a0 + l1 * a1;
#pragma unroll
            for (int db = 0; db < 4; ++db)
#pragma unroll
                for (int q = 0; q < 4; ++q) { const f32x4 pv = mg[(db * 4 + q) * 64];
#pragma unroll
                    for (int j = 0; j < 4; ++j) o[db][4 * q + j] = o[db][4 * q + j] * a0 + pv[j] * a1; }
            attn_store<128>(o, lsum, MIX + (size_t)(b * SEQ + tq) * DM + hd * 128, h);
        }
    }
    const int nu64 = 512 + (do_ctx ? 32 : 0);
    for (int rep2 = 0; rep2 < ATT_REP2; ++rep2)
    for (int u = blockIdx.x; u < nu64; u += gridDim.x) {
        U64 U;
        if (u < 256) {
            const int b = u >> 7, kvh = (u >> 6) & 1, qblk = u & 63; const int hq = kvh * 4 + (F.wave & 3), q0 = qblk * 64 + (F.wave >> 2) * 32;
            U.qrow = QS + ((size_t)(b * 8 + hq) * NKEY + q0 + ql) * 64; U.Kb = KS + (size_t)(b * 2 + kvh) * NKEY * 64; U.Vb = VS + (size_t)(b * 2 + kvh) * 64 * NKEY;
            U.lstart = max(qblk * 64 - 128, 0); U.nloc = (min(qblk * 64 + 191, SEQ - 1) - U.lstart) / 64 + 1;
            U.mode = 1; U.p0 = q0; U.p1 = 0; U.lo = q0 - 128 - 31; U.hi = q0 + 31 + 128; U.coloff = 0; U.rpb = nullptr;
            U.m0 = inp(F, I_SINK)[l * 8 + hq] * LOG2E; U.l0 = 1.f; U.orow = MIX + (size_t)(b * SEQ + q0 + ql) * DM + 1024 + hq * 64;
        } else if (u < 512) {
            const int w = u - 256; const int b = w >> 7, hd = (w >> 4) & 7, rblk = w & 15; const int r = rblk * 4 + (F.wave >> 2) * 2, cb = F.wave & 3;
            const int tq = (r + (ql >> 4)) * 64 + cb * 16 + (ql & 15);
            U.qrow = QN_ + ((size_t)(b * 8 + hd) * NKEY + tq) * 64; U.Kb = KN_ + (size_t)(b * 8 + hd) * NKEY * 64; U.Vb = VN_ + (size_t)(b * 8 + hd) * 64 * NKEY;
            const int ramin = min(max(rblk * 4 - 4, 0), 56), rbmax = min(max(rblk * 4 + 3 - 4, 0), 56) + 7;
            U.lstart = ramin * 64; U.nloc = rbmax - ramin + 1;
            U.mode = 2; U.p0 = r; U.p1 = cb; U.lo = min(max(r - 4, 0), 56); U.hi = min(max(r + 1 - 4, 0), 56) + 7; U.coloff = min(max(cb * 16 - 8, 0), 32);
            U.rpb = inp(F, I_RPB) + ((size_t)l * 8 + hd) * 15 * 31; U.m0 = -1e30f; U.l0 = 0.f; U.orow = MIX + (size_t)(b * SEQ + tq) * DM + 1536 + hd * 64;
        } else if (u < 528) {
            const int w = u - 512; const int b = w >> 3, kvh = (w >> 2) & 1, qblk = w & 3; const int hq = kvh * 4 + (F.wave & 3), q0 = qblk * 64 + (F.wave >> 2) * 32;
            U.qrow = QS + ((size_t)(b * 8 + hq) * NKEY + SEQ + q0 + ql) * 64; U.Kb = KS + (size_t)(b * 2 + kvh) * NKEY * 64; U.Vb = VS + (size_t)(b * 2 + kvh) * 64 * NKEY;
            U.lstart = 0; U.nloc = 0; U.mode = 0; U.p0 = 0; U.p1 = 0; U.lo = 0; U.hi = 0; U.coloff = 0; U.rpb = nullptr;
            U.m0 = inp(F, I_SINK)[l * 8 + hq] * LOG2E; U.l0 = 1.f; U.orow = MIX + (size_t)(NLAT + b * CTXL + q0 + ql) * DM + 1024 + hq * 64;
        } else {
            const int w = u - 528; const int b = w >> 3, hd = w & 7; const int q0 = F.wave * 32;
            U.qrow = QN_ + ((size_t)(b * 8 + hd) * NKEY + SEQ + q0 + ql) * 64; U.Kb = KN_ + (size_t)(b * 8 + hd) * NKEY * 64; U.Vb = VN_ + (size_t)(b * 8 + hd) * 64 * NKEY;
            U.lstart = 0; U.nloc = 0; U.mode = 0; U.p0 = 0; U.p1 = 0; U.lo = 0; U.hi = 0; U.coloff = 0; U.rpb = nullptr;
            U.m0 = -1e30f; U.l0 = 0.f; U.orow = MIX + (size_t)(NLAT + b * CTXL + q0 + ql) * DM + 1536 + hd * 64;
        }
        run_wg64(F, U, h, ql);
    }
    if (do_ctx) for (int u = gridDim.x >= 8 ? F.gw - ((int)gridDim.x - 8) * NWAVES : F.gw; u >= 0 && u < 64; u += F.ngw) {
        const int b = u >> 5, hd = (u >> 3) & 3, qt = u & 7; const int bh = b * 4 + hd; const int kq = SEQ + qt * 32 + ql;
        bf16x8 qf[12]; load_q<192>(qf, QM + ((size_t)bh * NKEY + kq) * 192, h);
        f32x16 o[4]; zero_o<128>(o); float m = -1e30f, lsum = 0.f;
        const unsigned char* kimg = KI + (size_t)bh * KIMG_BH + lane * 16; const unsigned char* vimg = VI + (size_t)bh * VIMG_BH + lane * 16;
        for (int t = SEQ / 32; t < NKEY / 32; ++t) {
            f32x16 s;
#pragma unroll
            for (int j = 0; j < 16; ++j) s[j] = 0.f;
#pragma unroll
            for (int kk = 0; kk < 12; ++kk) { const bf16x8 kf = *(const bf16x8*)(kimg + (size_t)t * 12288 + kk * 1024); s = MFMA32(kf, qf[kk], s); }
            bf16x8 vf[2][4];
#pragma unroll
            for (int st = 0; st < 2; ++st)
#pragma unroll
                for (int db = 0; db < 4; ++db) vf[st][db] = *(const bf16x8*)(vimg + (size_t)t * 8192 + (st * 4 + db) * 1024);
            attn_softmax_pv<128>(s, vf, m, lsum, o, C_MLA);
        }
        attn_store<128>(o, lsum, MIX + (size_t)(NLAT + b * CTXL + qt * 32 + ql) * DM + hd * 128, h);
    }
}

DI void convfix_phase(const Args& a, Frame& F, int l, int nrows) {
    const float* RAW = (const float*)(a.ws + WS_RAW); bf16* G = (bf16*)(a.ws + WS_G);
    const float* cw = inp(F, I_CONVW) + (size_t)l * 3 * FF2; const float* cb = inp(F, I_CONVB) + (size_t)l * FF2;
    const int ntile = nrows / 256; const int gt = F.gw * 64 + F.lane, ngt = F.ngw * 64;
    for (int it = gt; it < ntile * 2 * (FF / 4); it += ngt) {
        const int c = (it % (FF / 4)) * 4, e = (it / (FF / 4)) & 1, pm = it / (2 * (FF / 4));
        const bool seq_start = (pm == 0) || (pm == 16) || (pm >= 32), seq_end = (pm == 15) || (pm == 31) || (pm >= 32);
        const float* r0 = RAW + (size_t)pm * 4 * FF2;
        const float* pr = e == 0 ? (seq_start ? nullptr : r0 - 4 * FF2 + 3 * FF2) : r0 + 2 * FF2;
        const float* cr = e == 0 ? r0 : r0 + 3 * FF2;
        const float* nr = e == 0 ? r0 + FF2 : (seq_end ? nullptr : r0 + 4 * FF2);
        const f32x4 z = {0.f, 0.f, 0.f, 0.f};
        const f32x4 pg = pr ? *(const f32x4*)(pr + c) : z, pv = pr ? *(const f32x4*)(pr + FF + c) : z;
        const f32x4 cg = *(const f32x4*)(cr + c), cv = *(const f32x4*)(cr + FF + c);
        const f32x4 ng = nr ? *(const f32x4*)(nr + c) : z, nv = nr ? *(const f32x4*)(nr + FF + c) : z;
        const f32x4 gg = pg * *(const f32x4*)(cw + c) + cg * *(const f32x4*)(cw + FF2 + c) + ng * *(const f32x4*)(cw + 2 * FF2 + c) + *(const f32x4*)(cb + c);
        const f32x4 vv = pv * *(const f32x4*)(cw + FF + c) + cv * *(const f32x4*)(cw + FF2 + FF + c) + nv * *(const f32x4*)(cw + 2 * FF2 + FF + c) + *(const f32x4*)(cb + FF + c);
        v2u o; o.x = pk2(silu_f(gg.x) * vv.x, silu_f(gg.y) * vv.y); o.y = pk2(silu_f(gg.z) * vv.z, silu_f(gg.w) * vv.w);
        *(v2u*)(G + (size_t)(pm * 256 + (e ? 255 : 0)) * FF + c) = o;
    }
}

#ifndef G_ABL
#define G_ABL 0
#endif
constexpr int PH_PER_LAYER = 11, N_PHASES = 1 + DEPTH * PH_PER_LAYER;
__global__ void __launch_bounds__(NTHREADS, 2) mega_fwd(Args args) {
    extern __shared__ __attribute__((aligned(16))) unsigned char lds_raw[];
    Frame F;
    F.lds = (LAS unsigned char*)lds_raw;
    const int wave0 = __builtin_amdgcn_readfirstlane((int)threadIdx.x >> 6);
    F.lane = fresh_lane(); F.wave = wave0; F.tid = wave0 * 64 + F.lane;
    F.gw = blockIdx.x * NWAVES + F.wave; F.ngw = gridDim.x * NWAVES;
    volatile LAS unsigned* MISC = (volatile LAS unsigned*)(F.lds + MISC_OFF);
    for (int u = F.tid; u < (PTAB_OFF - LDSCTL_OFF) / 4; u += NTHREADS) ((LAS unsigned*)(F.lds + LDSCTL_OFF))[u] = 0u;
    if (F.tid < N_IN) *(LAS unsigned long long*)(F.lds + PTAB_OFF + 8 * F.tid) = (unsigned long long)args.in[F.tid];
    __syncthreads();
    unsigned char* ws = args.ws;
    const int lo = args.ph_lo, hi = args.ph_hi;
    XcdBarrier bar; bar.bar = (unsigned*)(ws + WS_CTL) + CW_BAR; bar.x = 0; bar.st = nullptr; bar.w0 = wave0;
    if (hi - lo > 1) bar = xcd_barrier_post((unsigned*)(ws + WS_CTL) + CW_BAR, MISC + 8, wave0);
#ifndef PH_MASK
#define PH_MASK 0xFFF
#endif
#define PHEN(j) ((((PH_MASK) >> (j)) & 1) != 0)
#ifndef PH_DUP
#define PH_DUP 0
#endif
#define NREP(j) (1 + (((PH_DUP) >> (j)) & 1))
#define IN(k) (lo <= (k) && (k) < hi)
#define FRESH() do { F.lane = fresh_lane(); F.wave = wave0; F.tid = wave0 * 64 + F.lane; F.gw = blockIdx.x * NWAVES + wave0; } while (0)
#define SEAM(k) do { if (IN(k) && IN((k) + 1)) xcd_barrier(bar); } while (0)

    if (PHEN(0) && IN(0)) for (int rep = 0; rep < NREP(0); ++rep) { FRESH(); p0_prologue(args, F, rep); } SEAM(0);

    for (int l = 0; l < DEPTH; ++l) {
        const int p0 = 1 + l * PH_PER_LAYER;
        const bool upd = l < DEPTH - 1;
        const int mrows = upd ? NROW : NLAT;
        const float* xlat = l == 0 ? inp(F, I_X) : (const float*)(ws + WS_X);
        const float* xctx = l == 0 ? inp(F, I_CTX) : (const float*)(ws + WS_X) + (size_t)NLAT * DM;
        float* xo_lat = (float*)(ws + WS_X); float* xo_ctx = (float*)(ws + WS_X) + (size_t)NLAT * DM;
        const float* modl = (const float*)(ws + WS_MOD) + (size_t)l * 3 * 12288;
        bf16* H = (bf16*)(ws + WS_H);
        float* slab = (float*)(ws + WS_SLAB);
        float* dummy = (float*)(ws + WS_AUP);
        if (PHEN(1) && IN(p0 + 0)) for (int rep = 0; rep < NREP(1); ++rep) { FRESH(); norm_phase(F, xlat, xctx, inp(F, I_GMIX) + l * DM, modl, 0, 1, H, NROW, slab, l > 0 ? 11 : 0, modl - 3 * 12288 + 2 * 12288 + 5 * DM, xo_ctx, l == 0); } SEAM(p0 + 0);
        if (PHEN(2) && IN(p0 + 1)) for (int rep = 0; rep < NREP(2); ++rep) { FRESH(); pg8::Gemm g{H, (const bf16*)(ws + WS_WIN) + (size_t)l * INP * DM, NROW, INP, DM, DM}; pg8::StaticOrder S; S.init(NROW, INP, gridDim.x, (int)blockIdx.x);
            pg8::EpiBf16S E{(bf16*)(ws + WS_P), INP, 0, nullptr};
            pg8::gemm_phase<pg8::EpiBf16S, pg8::StaticOrder, true, true>(F.lds + RING_OFF, g, S, E, wave0); } SEAM(p0 + 1);
        if (PHEN(3) && IN(p0 + 2)) for (int rep = 0; rep < NREP(3); ++rep) { FRESH(); prep_phase(args, F, l, rep); } SEAM(p0 + 2);
        if (PHEN(4) && IN(p0 + 3)) for (int rep = 0; rep < NREP(4); ++rep) { FRESH();
            { pg8::Gemm g{(const bf16*)(ws + WS_QN), (const bf16*)(ws + WS_WQB) + (size_t)l * 768 * 512, NROW, 768, 512, 512}; pg8::StaticOrder S; S.init(NROW, 768, gridDim.x, (int)blockIdx.x);
              pg8::EpiMlaQ E{(bf16*)(ws + WS_QMLA), inp(F, I_QNN) + l * 128, inp(F, I_QRN) + l * 64, (const f32x2*)(ws + WS_ROPE), (LAS float*)(F.lds + XB_OFF)}; pg8::gemm_phase<pg8::EpiMlaQ, pg8::StaticOrder, true, true>(F.lds + RING_OFF, g, S, E, wave0); }
            { pg8::Gemm g{(const bf16*)(ws + WS_KVN), (const bf16*)(ws + WS_WKVB) + (size_t)l * 1024 * 256, NROW, 1024, 256, 256}; pg8::StaticOrder S; S.init(NROW, 1024, gridDim.x, (int)((blockIdx.x + gridDim.x - 102 % gridDim.x) % gridDim.x));
              pg8::EpiMlaKV E{ws + WS_KMLA, ws + WS_VTMLA, inp(F, I_KNN) + l * 128, (LAS float*)(F.lds + XB_OFF)}; pg8::gemm_phase<pg8::EpiMlaKV, pg8::StaticOrder, true, true>(F.lds + RING_OFF, g, S, E, wave0); }
            { pg8::Gemm g{(const bf16*)(ws + WS_WOP) + (size_t)l * DM * 512, (const bf16*)(ws + WS_WPOOL) + (size_t)l * 512 * 512, DM, 512, 512, 512}; pg8::StaticOrder S; S.init(DM, 512, gridDim.x, (int)((blockIdx.x + gridDim.x - 238 % gridDim.x) % gridDim.x));
              pg8::EpiBf16S E{(bf16*)(ws + WS_WOUT) + (size_t)l * DM * DM, DM, 512, nullptr}; pg8::gemm_phase<pg8::EpiBf16S, pg8::StaticOrder, true, true>(F.lds + RING_OFF, g, S, E, wave0); }
        } SEAM(p0 + 3);
        if (PHEN(6) && IN(p0 + 5)) for (int rep = 0; rep < NREP(6); ++rep) { FRESH(); attn_phase(args, F, l, upd); } SEAM(p0 + 5);
        if (PHEN(7) && IN(p0 + 6)) for (int rep = 0; rep < NREP(7); ++rep) { FRESH();
            if (upd && !(rep > 0 && (G_ABL & 1))) { pg8::Gemm g{(const bf16*)(ws + WS_MIX), (const bf16*)(ws + WS_WOUT) + (size_t)l * DM * DM, NROW, DM, 256, DM};
              const int G_ = (int)gridDim.x, rank = ((int)blockIdx.x % 8) * (G_ / 8) + (int)blockIdx.x / 8; pg8::SplitOrder S{32, 2, 8, 8, G_, (G_ % 8 == 0) ? (rank + 128) % G_ : (int)blockIdx.x};
              pg8::EpiSlab E{slab, 32, NCTX, DM};
              pg8::gemm_phase<pg8::EpiSlab, pg8::SplitOrder, true, true>(F.lds + RING_OFF, g, S, E, wave0); }
            { pg8::Gemm g{(const bf16*)(ws + WS_MIX), (const bf16*)(ws + WS_WOUT) + (size_t)l * DM * DM, NLAT, DM, DM, DM}; pg8::StaticOrder S; S.init(NLAT, DM, gridDim.x, (int)blockIdx.x);
              pg8::EpiResidNorm E{xlat, xo_lat, modl + 2 * DM, inp(F, I_GFFN) + l * DM, modl + 3 * DM, modl + 4 * DM, H, (unsigned*)(ws + WS_AUP) + (8u << 20), (unsigned*)(ws + WS_CTL) + CW_PANEL, 64u * (unsigned)(2 * l + 1)};
              pg8::gemm_phase<pg8::EpiResidNorm, pg8::StaticOrder, true, true>(F.lds + RING_OFF, g, S, E, wave0); } } SEAM(p0 + 6);
        if (upd) { if (PHEN(8) && IN(p0 + 7)) for (int rep = 0; rep < NREP(8); ++rep) { FRESH(); norm_phase(F, xo_lat, xctx, inp(F, I_GFFN) + l * DM, modl, 3, 4, H, mrows, slab, 8, modl + 2 * 12288 + 2 * DM, xo_ctx, false); } SEAM(p0 + 7); }
        if (PHEN(9) && IN(p0 + 8)) for (int rep = 0; rep < NREP(9); ++rep) { FRESH(); pg8::Gemm g{H, (const bf16*)(ws + WS_WUP) + (size_t)l * FF2 * DM, mrows, FF2, DM, DM}; pg8::StaticOrder S; S.init(mrows, FF2, gridDim.x, (int)blockIdx.x);
            pg8::EpiConvGate E{(bf16*)(ws + WS_G), (float*)(ws + WS_RAW), inp(F, I_CONVW) + (size_t)l * 3 * FF2, inp(F, I_CONVB) + (size_t)l * FF2, (LAS float*)(F.lds + XB_OFF)};
            pg8::gemm_phase<pg8::EpiConvGate, pg8::StaticOrder, true, true>(F.lds + RING_OFF, g, S, E, wave0); } SEAM(p0 + 8);
        if (PHEN(10) && IN(p0 + 9)) for (int rep = 0; rep < NREP(10); ++rep) { FRESH(); convfix_phase(args, F, l, mrows); } SEAM(p0 + 9);
        if (PHEN(11) && IN(p0 + 10)) for (int rep = 0; rep < NREP(11); ++rep) { FRESH();
            if (upd && !(rep > 0 && (G_ABL & 1))) { pg8::Gemm g{(const bf16*)(ws + WS_G), (const bf16*)(ws + WS_WDN) + (size_t)l * DM * FF, NROW, DM, 512, FF};
              const int G_ = (int)gridDim.x, rank = ((int)blockIdx.x % 8) * (G_ / 8) + (int)blockIdx.x / 8; pg8::SplitOrder S{32, 2, 8, 11, G_, (G_ % 8 == 0) ? (rank + 176) % G_ : (int)blockIdx.x};
              pg8::EpiSlab E{slab, 32, NCTX, DM};
              pg8::gemm_phase<pg8::EpiSlab, pg8::SplitOrder, true, true>(F.lds + RING_OFF, g, S, E, wave0); }
            { pg8::Gemm g{(const bf16*)(ws + WS_G), (const bf16*)(ws + WS_WDN) + (size_t)l * DM * FF, NLAT, DM, FF, FF}; pg8::StaticOrder S; S.init(NLAT, DM, gridDim.x, (int)blockIdx.x);
              if (upd) {
                  pg8::EpiResidNorm E{xo_lat, xo_lat, modl + 5 * DM, inp(F, I_GMIX) + (l + 1) * DM, modl + 3 * 12288, modl + 3 * 12288 + DM, H, (unsigned*)(ws + WS_AUP) + (8u << 20), (unsigned*)(ws + WS_CTL) + CW_PANEL, 64u * (unsigned)(2 * l + 2)};
                  pg8::gemm_phase<pg8::EpiResidNorm, pg8::StaticOrder, true, true>(F.lds + RING_OFF, g, S, E, wave0);
              } else { pg8::EpiResid E{xo_lat, xo_ctx, args.out, xo_ctx, modl + 5 * DM};
                  pg8::gemm_phase<pg8::EpiResid, pg8::StaticOrder, true, true>(F.lds + RING_OFF, g, S, E, wave0); } } } SEAM(p0 + 10);
    }
#undef IN
#undef SEAM
}

#ifndef MK_N_LAUNCHES
#define MK_N_LAUNCHES 1
#endif
extern "C" void kernel_launch(void* const* d_in, const int* in_sizes, int n_in, void* d_out, int out_size, void* d_ws, size_t ws_size, hipStream_t stream) {
    static int grid = 0;
    if (grid == 0) {
        if (n_in != N_IN || out_size != NLAT * DM || ws_size < WS_END) { fprintf(stderr, "kernel_launch: unexpected shapes: n_in %d out %d ws %zu (need %zu)\n", n_in, out_size, ws_size, (size_t)WS_END); grid = -1; return; }
        int dev = 0, cus = 0, per_cu = 0;
        if (hipGetDevice(&dev) != hipSuccess || hipDeviceGetAttribute(&cus, hipDeviceAttributeMultiprocessorCount, dev) != hipSuccess) { grid = -1; return; }
        if (hipFuncSetAttribute((const void*)mega_fwd, hipFuncAttributeMaxDynamicSharedMemorySize, LDS_BYTES) != hipSuccess) { fprintf(stderr, "kernel_launch: hipFuncSetAttribute failed\n"); grid = -1; return; }
        if (hipOccupancyMaxActiveBlocksPerMultiprocessor(&per_cu, (const void*)mega_fwd, NTHREADS, LDS_BYTES) != hipSuccess || per_cu < 1) fprintf(stderr, "kernel_launch: occupancy query reports %d\n", per_cu);
        (void)hipGetLastError();
        grid = cus;
    }
    if (grid < 0) return;
    (void)hipMemsetAsync((char*)d_ws + WS_CTL, 0, CTL_ZERO_BYTES, stream);
    Args a{};
    for (int i = 0; i < N_IN; ++i) a.in[i] = (const float*)d_in[i];
    a.out = (float*)d_out; a.ws = (unsigned char*)d_ws;
    if (MK_N_LAUNCHES == 1) { a.ph_lo = 0; a.ph_hi = N_PHASES; hipLaunchKernelGGL(mega_fwd, dim3(grid), dim3(NTHREADS), LDS_BYTES, stream, a); }
    else for (int p = 0; p < N_PHASES; ++p) { a.ph_lo = p; a.ph_hi = p + 1; hipLaunchKernelGGL(mega_fwd, dim3(grid), dim3(NTHREADS), LDS_BYTES, stream, a); }
}
```
